# Optimizing an MI355X kernel written in HIP

```python
import math
import jax, jax.numpy as jnp
from jax import lax
import numpy as np


D_MODEL = 1024
BATCH = 16
SEQ = 2048
DEPTH = 1

HEAD_DIM = 64
FOX_HEADS = 12
DIL_HEADS = 12
MEM_HEADS = 4
MEM_HEAD_DIM = 128
MEM_LEN = 256
FOX_W = FOX_HEADS * HEAD_DIM
DIL_W = DIL_HEADS * HEAD_DIM
MEM_W = MEM_HEADS * MEM_HEAD_DIM
MIX_W = FOX_W + DIL_W + MEM_W
DILATIONS = ((128, 1), (512, 4), (2048, 16))
BLOCK = 128
ROPE_THETA = 500000.0
ROPE_DIM = HEAD_DIM // 4
RMS_EPS = 1e-6
NEG_INF = -1e30
IN_SIZES = [FOX_W] * 4 + [FOX_HEADS] + [DIL_W] * 4 + [MEM_W] * 2
IN_W = sum(IN_SIZES)

kernel_name = 'hymba_fox_dilated_memory_block'


def rmsnorm(x, g):
    xf = x.astype(jnp.float32)
    y = xf * lax.rsqrt(jnp.mean(xf * xf, axis=-1, keepdims=True) + RMS_EPS)
    return (y * g.astype(jnp.float32)).astype(x.dtype)


def rope_partial(t, pos):
    half = ROPE_DIM // 2
    inv_freq = 1.0 / (ROPE_THETA ** (jnp.arange(0, ROPE_DIM, 2, dtype=jnp.float32) / ROPE_DIM))
    ang = pos[:, None] * inv_freq[None, :]
    cos = jnp.cos(ang)[None, :, None, :]
    sin = jnp.sin(ang)[None, :, None, :]
    tr = t[..., :ROPE_DIM].astype(jnp.float32)
    t1, t2 = tr[..., :half], tr[..., half:]
    rot = jnp.concatenate([t1 * cos - t2 * sin, t2 * cos + t1 * sin], axis=-1)
    return jnp.concatenate([rot.astype(t.dtype), t[..., ROPE_DIM:]], axis=-1)


def forgetting_attention(q, k, v, logf):
    B, S, H, E = q.shape
    scale = 1.0 / math.sqrt(E)
    c = jnp.cumsum(logf, axis=1).transpose(0, 2, 1)
    vf = v.astype(jnp.float32)
    outs = []
    for i in range(S // BLOCK):
        q0, q1 = i * BLOCK, (i + 1) * BLOCK
        s = jnp.einsum('bqhe,bkhe->bhqk', q[:, q0:q1], k[:, :q1]).astype(jnp.float32) * scale
        s = s + c[:, :, q0:q1, None] - c[:, :, None, :q1]
        mask = (q0 + jnp.arange(BLOCK))[:, None] >= jnp.arange(q1)[None, :]
        s = jnp.where(mask[None, None], s, NEG_INF)
        p = jax.nn.softmax(s, axis=-1)
        outs.append(jnp.einsum('bhqk,bkhe->bqhe', p, vf[:, :q1]))
    return jnp.concatenate(outs, axis=1)


def dilated_pattern(q, k, v, dilation, n_steps):
    B, S, H, E = q.shape
    L = S // dilation
    nb = -(-L // BLOCK)
    Lp = nb * BLOCK
    scale = 1.0 / math.sqrt(E)

    def to_blocks(t):
        t = t.reshape(B, L, dilation, H, E)
        t = jnp.pad(t, ((0, 0), (0, Lp - L), (0, 0), (0, 0), (0, 0)))
        return t.reshape(B, nb, BLOCK, dilation, H, E)

    def with_prev(t):
        prev = jnp.pad(t, ((0, 0), (1, 0), (0, 0), (0, 0), (0, 0), (0, 0)))[:, :nb]
        return jnp.concatenate([prev, t], axis=2)

    qb = to_blocks(q)
    kc = with_prev(to_blocks(k))
    vc = with_prev(to_blocks(v)).astype(jnp.float32)
    s = jnp.einsum('bnqrhe,bnkrhe->bnrhqk', qb, kc).astype(jnp.float32) * scale
    lq = jnp.arange(nb)[:, None] * BLOCK + jnp.arange(BLOCK)[None, :]
    lk = (jnp.arange(nb)[:, None] - 1) * BLOCK + jnp.arange(2 * BLOCK)[None, :]
    delta = lq[:, :, None] - lk[:, None, :]
    mask = (delta >= 0) & (delta <= n_steps) & (lk[:, None, :] >= 0)
    s = jnp.where(mask[None, :, None, None], s, NEG_INF)
    m = jnp.max(s, axis=-1, keepdims=True)
    e = jnp.exp(s - m)
    den = jnp.sum(e, axis=-1)
    num = jnp.einsum('bnrhqk,bnkrhe->bnqrhe', e, vc)
    num = num.reshape(B, Lp, dilation, H, E)[:, :L].reshape(B, S, H, E)

    def rows(t):
        t = t.transpose(0, 1, 4, 2, 3).reshape(B, Lp, dilation, H)
        return t[:, :L].reshape(B, S, H)

    return num, rows(den), rows(m[..., 0])


def dilated_attention(q, k, v):
    parts = [dilated_pattern(q, k, v, d, w // d) for (w, d) in DILATIONS]
    m_all = parts[0][2]
    for p in parts[1:]:
        m_all = jnp.maximum(m_all, p[2])
    num_tot = 0.0
    den_tot = 0.0
    for num, den, m in parts:
        w = jnp.exp(m - m_all)
        num_tot = num_tot + num * w[..., None]
        den_tot = den_tot + den * w
    return num_tot / den_tot[..., None]


def memory_attention(q, mk, mv):
    scale = 1.0 / math.sqrt(q.shape[-1])
    s = jnp.einsum('bqhe,bkhe->bhqk', q, mk).astype(jnp.float32) * scale
    p = jax.nn.softmax(s, axis=-1)
    return jnp.einsum('bhqk,bkhe->bqhe', p, mv.astype(jnp.float32))


def setup_inputs(seed: int = 0) -> dict:
    key = jax.random.key(seed)
    ks = jax.random.split(key, 10)
    f32 = jnp.float32
    x = jax.random.normal(ks[0], (BATCH, SEQ, D_MODEL), f32)
    mem = jax.random.normal(ks[1], (BATCH, MEM_LEN, D_MODEL), f32)
    norm_g = 1.0 + 0.02 * jax.random.normal(ks[2], (DEPTH, D_MODEL), f32)
    w_in = jax.random.normal(ks[3], (DEPTH, D_MODEL, IN_W), f32) * D_MODEL ** -0.5
    b_forget = jax.random.uniform(ks[4], (DEPTH, FOX_HEADS), f32, 1.0, 4.0)
    mem_norm_g = 1.0 + 0.02 * jax.random.normal(ks[5], (DEPTH, D_MODEL), f32)
    w_mem_kv = jax.random.normal(ks[6], (DEPTH, D_MODEL, 2 * MEM_W), f32) * D_MODEL ** -0.5
    w_out = jax.random.normal(ks[7], (DEPTH, MIX_W, D_MODEL), f32) * MIX_W ** -0.5
    final_norm_g = 1.0 + 0.02 * jax.random.normal(ks[8], (D_MODEL,), f32)
    return {'x': x, 'mem': mem, 'norm_g': norm_g, 'w_in': w_in, 'b_forget': b_forget,
            'mem_norm_g': mem_norm_g, 'w_mem_kv': w_mem_kv, 'w_out': w_out,
            'final_norm_g': final_norm_g}


def reference(x, mem, norm_g, w_in, b_forget, mem_norm_g, w_mem_kv, w_out, final_norm_g):
    B, S, _ = x.shape
    pos = jnp.arange(S, dtype=jnp.float32)
    split_idx = np.cumsum(IN_SIZES)[:-1].tolist()
    for l in range(DEPTH):
        h = rmsnorm(x, norm_g[l])
        proj = h @ w_in[l]
        (fq, fk, fv, fg, flog, dq, dk, dv, dg, mq, mg) = jnp.split(proj, split_idx, axis=-1)

        logf = jax.nn.log_sigmoid((flog + b_forget[l]).astype(jnp.float32))
        hs = (B, S, FOX_HEADS, HEAD_DIM)
        fox = forgetting_attention(fq.reshape(hs), fk.reshape(hs), fv.reshape(hs), logf)
        fox = fox.reshape(B, S, FOX_W).astype(x.dtype)

        hs = (B, S, DIL_HEADS, HEAD_DIM)
        dqr = rope_partial(dq.reshape(hs), pos)
        dkr = rope_partial(dk.reshape(hs), pos)
        dil = dilated_attention(dqr, dkr, dv.reshape(hs)).reshape(B, S, DIL_W).astype(x.dtype)

        mh = rmsnorm(mem, mem_norm_g[l])
        mk, mv = jnp.split(mh @ w_mem_kv[l], 2, axis=-1)
        ms = (B, mem.shape[1], MEM_HEADS, MEM_HEAD_DIM)
        memo = memory_attention(mq.reshape(B, S, MEM_HEADS, MEM_HEAD_DIM), mk.reshape(ms), mv.reshape(ms))
        memo = memo.reshape(B, S, MEM_W).astype(x.dtype)

        y = jnp.concatenate([fox * jax.nn.silu(fg), dil * jax.nn.silu(dg), memo * jax.nn.silu(mg)], axis=-1)
        x = x + y @ w_out[l]
    return rmsnorm(x, final_norm_g)
```

```cpp
#include <hip/hip_runtime.h>
#include <hip/hip_bf16.h>
#include <cstdio>
#include <cstdint>
#include <cmath>

constexpr int BATCH = 16, SEQ = 2048, DM = 1024, M = BATCH * SEQ;
constexpr int INW = 7180, NPROJ = 7168;
constexpr int MEMLEN = 256, MMEM = BATCH * MEMLEN;
constexpr int NH = 12, HD = 64, MH = 4, MHD = 128;
constexpr float RMS_EPS = 1e-6f;
constexpr float LOG2E = 1.4426950408889634f;
constexpr float C2 = 0.125f * LOG2E;
constexpr float C2M = 0.08838834764831845f * LOG2E;
constexpr int C_FQ = 0, C_DQ = 768, C_MQ = 1536, C_FK = 2048, C_FV = 2816, C_FG = 3584, C_DK = 4352, C_DV = 5120, C_DG = 5888, C_MG = 6656;
constexpr int S_FQ = 0, S_FK = 768, S_FV = 1536, S_FG = 2304, S_FLOG = 3072, S_DQ = 3084, S_DK = 3852, S_DV = 4620, S_DG = 5388, S_MQ = 6156, S_MG = 6668;
__host__ __device__ __forceinline__ int src_col_of_dst(int d) {
    if (d < 768) return S_FQ + d;
    if (d < 1536) return S_DQ + d - 768;
    if (d < 2048) return S_MQ + d - 1536;
    if (d < 2816) return S_FK + d - 2048;
    if (d < 3584) return S_FV + d - 2816;
    if (d < 4352) return S_FG + d - 3584;
    if (d < 5120) return S_DK + d - 4352;
    if (d < 5888) return S_DV + d - 5120;
    if (d < 6656) return S_DG + d - 5888;
    return S_MG + d - 6656;
}

constexpr size_t MiB = 1u << 20;
constexpr size_t WS_CTL = 0, CTL_ZERO_BYTES = 1 * MiB;
constexpr size_t WS_WIN = 2 * MiB;
constexpr size_t WS_WOUT = 16 * MiB;
constexpr size_t WS_WMKV = 20 * MiB;
constexpr size_t WS_ROPE = 22 * MiB;
constexpr size_t WS_LOGF = 23 * MiB;
constexpr size_t WS_KAUG = 25 * MiB;
constexpr size_t WS_SSQ = 31 * MiB;
constexpr size_t WS_PROJ = 34 * MiB;
constexpr size_t WS_END = WS_PROJ + (size_t)M * NPROJ * 2;
constexpr size_t DO_XN = 0;
constexpr size_t DO_MN = 64 * MiB;
constexpr size_t DO_MKV = 72 * MiB;
constexpr int CW_TMO = 0, CW_CODE = 1, CW_QUEUE = 64, CW_BAR = 4096;

constexpr int NWAVES = 8;
constexpr int RING_OFF = 0, RING_BYTES = 131072;
constexpr int LDSCTL_OFF = RING_BYTES, MISC_OFF = LDSCTL_OFF + 320;
constexpr int LDS_BYTES = 147456;

#define GAS __attribute__((address_space(1)))
#define LAS __attribute__((address_space(3)))
typedef unsigned short bf16;
typedef unsigned v4u __attribute__((ext_vector_type(4)));
typedef GAS unsigned gu32;
#define RLX_AGENT __ATOMIC_RELAXED, __HIP_MEMORY_SCOPE_AGENT
#define LDS_WAIT() asm volatile("s_waitcnt lgkmcnt(0)" ::: "memory")
#define VM_WAIT() asm volatile("s_waitcnt vmcnt(0)" ::: "memory")
__device__ __forceinline__ unsigned f2bf(float f) { unsigned u = __builtin_bit_cast(unsigned, f); return (u + 0x7fffu + ((u >> 16) & 1u)) >> 16; }
__device__ __forceinline__ unsigned pk2(float lo, float hi) { return f2bf(lo) | (f2bf(hi) << 16); }
__device__ __forceinline__ float bflo(unsigned u) { return __uint_as_float(u << 16); }
__device__ __forceinline__ float bfhi(unsigned u) { return __uint_as_float(u & 0xffff0000u); }
__device__ __forceinline__ float wave_sum(float v) {
#pragma unroll
    for (int o = 1; o < 64; o <<= 1) v += __shfl_xor(v, o);
    return v;
}

#ifndef N_LAUNCH_MODE
#define N_LAUNCH_MODE 0
#endif
namespace pg8 {
#define PG8_LAS __attribute__((address_space(3)))
typedef unsigned short bf16_t;
typedef short bf16x8 __attribute__((ext_vector_type(8)));
typedef float f32x4 __attribute__((ext_vector_type(4)));
typedef unsigned u32x4 __attribute__((ext_vector_type(4)));
constexpr int BM = 256, BK = 64, HALF = 128, HTB = HALF * BK * 2  , STAGE_BYTES = 8 * HTB, NXCD = 8, WGM = 8;

__host__ __device__ __forceinline__ int lds_byte(int r, int c) { const int st = (r >> 4) * 2 + (c >> 5), rr = r & 15, cc = c & 31, ob = rr * 64 + cc * 2; return st * 1024 + (ob ^ (((ob >> 9) & 1) << 5)); }
__host__ __device__ __forceinline__ void stage_rc(int b, int& R, int& C) { const int st = b / 1024, sb = b % 1024, swz = sb ^ (((sb >> 9) & 1) << 5); R = (st >> 1) * 16 + swz / 64; C = (st & 1) * 32 + (swz % 64) / 2; }
__host__ __device__ __forceinline__ int perm32(int rho) { const int n = rho >> 4, i = rho & 15; return 8 * (i >> 2) + 4 * n + (i & 3); }

struct Unit { int pm, pn; };
struct Gemm { const bf16_t* A; const bf16_t* Bt; int M, N, K, lda; };

struct StaticOrder {
    int nM, nN, nwg, G, c;
    __host__ __device__ void init(int M, int N, int G_, int c_) { nM = M / BM; nN = N / BM; nwg = nM * nN; G = G_; c = c_; }
    __host__ __device__ bool next(int i, Unit& u) const {
        const long L = (long)i * G + c; if (L >= nwg) return false;
        int wgid = (int)L; { const int q = nwg / NXCD, r = nwg % NXCD, xcd = wgid % NXCD, off = wgid / NXCD; wgid = (xcd < r ? xcd * (q + 1) : r * (q + 1) + (xcd - r) * q) + off; }
        const int nig = WGM * nN, gid = wgid / nig, fm = gid * WGM, gsz = (nM - fm) < WGM ? (nM - fm) : WGM;
        u.pm = fm + ((wgid % nig) % gsz); u.pn = (wgid % nig) / gsz; return true;
    }
    __device__ __forceinline__ void a_ready(const Unit&) const {}
    __device__ __forceinline__ void done(const Unit&) const {}
};

__device__ __forceinline__ unsigned cvt_pk_bf16(float lo, float hi) { unsigned r; asm volatile("v_cvt_pk_bf16_f32 %0, %1, %2" : "=v"(r) : "v"(lo), "v"(hi)); return r; }
__device__ __forceinline__ float silu_f(float v) { return v * __builtin_amdgcn_rcpf(1.0f + __builtin_amdgcn_exp2f(-1.4426950408889634f * v)); }

struct EpiPlain {
    static constexpr bool PERM = true, AFTER_DRAIN = false;
    bf16_t* O; int ldc;
    __device__ __forceinline__ void operator()(const f32x4 (&acc)[2][2][4][2], const Unit& u, int wr, int wc, int fr, int fq) const {
        const int row0 = u.pm * BM + wr * 64 + fr, col0 = u.pn * BM + wc * 32 + 8 * fq;
#pragma unroll
        for (int ai = 0; ai < 2; ++ai)
#pragma unroll
            for (int m = 0; m < 4; ++m) { bf16_t* rowp = O + (size_t)(row0 + ai * HALF + m * 16) * ldc + col0;
#pragma unroll
                for (int bj = 0; bj < 2; ++bj) { const f32x4 v0 = acc[ai][bj][m][0], v1 = acc[ai][bj][m][1];
                    u32x4 w; w.x = cvt_pk_bf16(v0[0], v0[1]); w.y = cvt_pk_bf16(v0[2], v0[3]); w.z = cvt_pk_bf16(v1[0], v1[1]); w.w = cvt_pk_bf16(v1[2], v1[3]);
                    *(u32x4*)(rowp + bj * HALF) = w; } }
    }
};

struct EpiProj {
    static constexpr bool PERM = true, AFTER_DRAIN = false;
    bf16_t* O; int ldc; const float* rope;
    float c2, c2m;
    __device__ __forceinline__ void operator()(const f32x4 (&acc)[2][2][4][2], const Unit& u, int wr, int wc, int fr, int fq) const {
        const int pn = u.pn;
        int kind; float sc = 1.f;
        if (pn < 3) { kind = 1; sc = c2; } else if (pn < 6) { kind = 2; sc = c2; } else if (pn < 8) { kind = 1; sc = c2m; } else if (pn < 14) kind = 0;
        else if (pn < 17) kind = 4; else if (pn < 20) kind = 3; else if (pn < 23) kind = 0; else kind = 4;
        const bool do_rope = (kind == 2 || kind == 3) && ((wc & 1) == 0);
        const int row0 = u.pm * BM + wr * 64 + fr, col0 = pn * BM + wc * 32 + 8 * fq;
#pragma unroll
        for (int ai = 0; ai < 2; ++ai)
#pragma unroll
            for (int m = 0; m < 4; ++m) { const int row = row0 + ai * HALF + m * 16; bf16_t* rowp = O + (size_t)row * ldc + col0;
                f32x4 cs[4];
                if (do_rope) { const f32x4* rp = (const f32x4*)(rope + (size_t)(row & 2047) * 16);
#pragma unroll
                    for (int i = 0; i < 4; ++i) cs[i] = rp[i]; }
#pragma unroll
                for (int bj = 0; bj < 2; ++bj) { f32x4 v0 = acc[ai][bj][m][0], v1 = acc[ai][bj][m][1];
                    if (do_rope) {
                        float p[8], v[8] = {v0[0], v0[1], v0[2], v0[3], v1[0], v1[1], v1[2], v1[3]};
#pragma unroll
                        for (int e = 0; e < 8; ++e) p[e] = __shfl_xor(v[e], 16);
                        const float sg = (fq == 0) ? -1.f : 1.f;
#pragma unroll
                        for (int e = 0; e < 8; ++e) { const float c = cs[e >> 1][(e & 1) * 2], s = cs[e >> 1][(e & 1) * 2 + 1]; const float r = v[e] * c + sg * p[e] * s; if (fq < 2) v[e] = r; }
                        v0 = (f32x4){v[0], v[1], v[2], v[3]}; v1 = (f32x4){v[4], v[5], v[6], v[7]};
                    }
                    if (kind == 4) {
#pragma unroll
                        for (int e = 0; e < 4; ++e) { v0[e] = silu_f(v0[e]); v1[e] = silu_f(v1[e]); }
                    }
                    v0 = v0 * sc; v1 = v1 * sc;
                    u32x4 w; w.x = cvt_pk_bf16(v0[0], v0[1]); w.y = cvt_pk_bf16(v0[2], v0[3]); w.z = cvt_pk_bf16(v1[0], v1[1]); w.w = cvt_pk_bf16(v1[2], v1[3]);
                    *(u32x4*)(rowp + bj * HALF) = w; } }
    }
};

struct EpiRes {
    static constexpr bool PERM = false, AFTER_DRAIN = false;
    const float* base; float* out; int ldc; float* ssq;
    __device__ __forceinline__ void operator()(const f32x4 (&acc)[2][2][4][2], const Unit& u, int wr, int wc, int fr, int fq) const {
        const int col0 = u.pn * BM + wc * 32 + 4 * fq;
#pragma unroll
        for (int ai = 0; ai < 2; ++ai)
#pragma unroll
            for (int m = 0; m < 4; ++m) { const int row = u.pm * BM + ai * HALF + wr * 64 + m * 16 + fr; const size_t off = (size_t)row * ldc + col0; float s = 0.f;
#pragma unroll
                for (int bj = 0; bj < 2; ++bj)
#pragma unroll
                    for (int n = 0; n < 2; ++n) { const f32x4 bs = *(const f32x4*)(base + off + bj * HALF + n * 16); const f32x4 o = bs + acc[ai][bj][m][n];
                        *(f32x4*)(out + off + bj * HALF + n * 16) = o; s += (o[0] * o[0] + o[1] * o[1]) + (o[2] * o[2] + o[3] * o[3]); }
                s += __shfl_xor(s, 16); s += __shfl_xor(s, 32);
                if (fq == 0) ssq[(size_t)row * 16 + u.pn * 4 + wc] = s; }
    }
};

template <class Epi, class Sched, bool ALIGN_EPI = false, bool SP2 = false>
__device__ __forceinline__ void gemm_phase(PG8_LAS unsigned char* lds, const Gemm g, const Sched& S, const Epi& E) {
    const int tid = threadIdx.x, wid = __builtin_amdgcn_readfirstlane(tid >> 6), lane = tid & 63, wr = wid >> 2, wc = wid & 3, fr = lane & 15, fq = lane >> 4;
    const int K = g.K, nt = K / BK;
    unsigned voffA[2], voffB[2];
#pragma unroll
    for (int i = 0; i < 2; ++i) { int R, C; stage_rc(tid * 16 + i * 8192, R, C); const int Rb = Epi::PERM ? ((R & ~31) + perm32(R & 31)) : R;
        voffA[i] = (unsigned)(R * g.lda + C) * 2u; voffB[i] = (unsigned)(Rb * K + C) * 2u; }
    const size_t kstep = (size_t)(BK * 2);
    const size_t hstepA = (size_t)HALF * g.lda * 2, hstepB = (size_t)HALF * K * 2;
    const size_t tstepA = 2 * hstepA, tstepB = 2 * hstepB;
    const unsigned ldsw = (unsigned)wid * 1024u;
    const int aoff = lds_byte(wr * 64 + fr, fq * 8), boff = lds_byte(wc * 32 + fr, fq * 8);
#define PG8_SA(b, h) (((b) * 2 + (h)) * HTB)
#define PG8_SB(b, h) ((4 + (b) * 2 + (h)) * HTB)
#define PG8_STAGE(bufoff, gbase, voff) do { _Pragma("unroll") for (int _i = 0; _i < 2; ++_i) \
        __builtin_amdgcn_global_load_lds((const unsigned*)((const char*)(gbase) + (voff)[_i]), (PG8_LAS unsigned*)(lds + (bufoff) + ldsw + _i * 8192), 16, 0, 0); } while (0)
#define PG8_LDA(dst, b, h) do { _Pragma("unroll") for (int m = 0; m < 4; ++m) _Pragma("unroll") for (int k = 0; k < 2; ++k) dst[m][k] = *(const PG8_LAS bf16x8*)(lds + PG8_SA(b, h) + aoff + m * 2048 + k * 1024); } while (0)
#define PG8_LDB(dst, b, h) do { _Pragma("unroll") for (int n = 0; n < 2; ++n) _Pragma("unroll") for (int k = 0; k < 2; ++k) dst[n][k] = *(const PG8_LAS bf16x8*)(lds + PG8_SB(b, h) + boff + n * 2048 + k * 1024); } while (0)
#define PG8_MMA(ai, bj, At, Bt) do { __builtin_amdgcn_s_setprio(1); _Pragma("unroll") for (int m = 0; m < 4; ++m) _Pragma("unroll") for (int n = 0; n < 2; ++n) _Pragma("unroll") for (int k = 0; k < 2; ++k) \
        acc[ai][bj][m][n] = __builtin_amdgcn_mfma_f32_16x16x32_bf16(Bt[n][k], At[m][k], acc[ai][bj][m][n], 0, 0, 0); __builtin_amdgcn_s_setprio(0); } while (0)
#define PG8_WAIT_V(n) asm volatile("s_waitcnt vmcnt(" #n ")" ::: "memory")
#define PG8_WAIT_L(n) asm volatile("s_waitcnt lgkmcnt(" #n ")" ::: "memory")
#define PG8_BAR __builtin_amdgcn_s_barrier()
#define PG8_SCHED __builtin_amdgcn_sched_barrier(0)
    Unit cur, nxt; int ui = 0;
    if (!S.next(0, cur)) return;
    f32x4 acc[2][2][4][2];
#pragma unroll
    for (int a = 0; a < 2; ++a)
#pragma unroll
        for (int b = 0; b < 2; ++b)
#pragma unroll
            for (int m = 0; m < 4; ++m)
#pragma unroll
                for (int n = 0; n < 2; ++n) acc[a][b][m][n] = (f32x4){0.f, 0.f, 0.f, 0.f};
    bf16x8 At[4][2], B0[2][2], B1[2][2];
    const char* cA = (const char*)g.A + (size_t)cur.pm * tstepA; const char* cB = (const char*)g.Bt + (size_t)cur.pn * tstepB;
    S.a_ready(cur);
    if constexpr (SP2) {
        PG8_STAGE(PG8_SB(0, 0), cB, voffB); PG8_STAGE(PG8_SB(0, 1), cB + hstepB, voffB); PG8_STAGE(PG8_SA(0, 0), cA, voffA); PG8_STAGE(PG8_SA(0, 1), cA + hstepA, voffA);
        if (wr == 1) PG8_BAR;
        PG8_WAIT_V(2); PG8_BAR;
        PG8_STAGE(PG8_SB(1, 0), cB + kstep, voffB); PG8_STAGE(PG8_SA(1, 0), cA + kstep, voffA); PG8_STAGE(PG8_SB(1, 1), cB + hstepB + kstep, voffB);
        PG8_WAIT_V(6); PG8_BAR;
    } else {
        PG8_STAGE(PG8_SB(0, 0), cB, voffB); PG8_STAGE(PG8_SA(0, 0), cA, voffA); PG8_STAGE(PG8_SB(0, 1), cB + hstepB, voffB); PG8_STAGE(PG8_SA(0, 1), cA + hstepA, voffA);
        if (wr == 1) PG8_BAR;
        PG8_WAIT_V(4); PG8_BAR;
        PG8_STAGE(PG8_SB(1, 0), cB + kstep, voffB); PG8_STAGE(PG8_SA(1, 0), cA + kstep, voffA); PG8_STAGE(PG8_SB(1, 1), cB + hstepB + kstep, voffB);
        PG8_WAIT_V(6); PG8_BAR;
    }
    for (;;) {
        const bool has_next = S.next(ui + 1, nxt);
        const char* nA = has_next ? (const char*)g.A + (size_t)nxt.pm * tstepA : cA; const char* nB = has_next ? (const char*)g.Bt + (size_t)nxt.pn * tstepB : cB;
        for (int t = 0; t < nt; t += 2) {
            const bool last = (t == nt - 2);
            const char* a1 = cA + (size_t)(t + 1) * kstep;
            const char* a2 = last ? nA : cA + (size_t)(t + 2) * kstep; const char* b2 = last ? nB : cB + (size_t)(t + 2) * kstep;
            const char* a3 = a2 + kstep; const char* b3 = b2 + kstep;
            if (last && has_next) S.a_ready(nxt);
            if constexpr (SP2) {
            PG8_LDB(B0, 0, 0); PG8_LDB(B1, 0, 1); PG8_SCHED; PG8_LDA(At, 0, 0); PG8_STAGE(PG8_SA(1, 1), a1 + hstepA, voffA);
            PG8_WAIT_V(8); PG8_WAIT_L(0); PG8_BAR; PG8_MMA(0, 0, At, B0); PG8_MMA(0, 1, At, B1); PG8_BAR; PG8_SCHED;
            PG8_LDA(At, 0, 1); PG8_STAGE(PG8_SB(0, 0), b2, voffB); PG8_STAGE(PG8_SB(0, 1), b2 + hstepB, voffB); PG8_STAGE(PG8_SA(0, 0), a2, voffA);
            PG8_WAIT_V(8); PG8_WAIT_L(0); PG8_BAR; PG8_MMA(1, 0, At, B0); PG8_MMA(1, 1, At, B1); PG8_BAR; PG8_SCHED;
            PG8_LDB(B0, 1, 0); PG8_LDB(B1, 1, 1); PG8_SCHED; PG8_LDA(At, 1, 0); PG8_STAGE(PG8_SA(0, 1), a2 + hstepA, voffA);
            PG8_WAIT_V(8); PG8_WAIT_L(0); PG8_BAR; PG8_MMA(0, 0, At, B0); PG8_MMA(0, 1, At, B1); PG8_BAR; PG8_SCHED;
            PG8_LDA(At, 1, 1); PG8_STAGE(PG8_SB(1, 0), b3, voffB); PG8_STAGE(PG8_SB(1, 1), b3 + hstepB, voffB); PG8_STAGE(PG8_SA(1, 0), a3, voffA);
            PG8_WAIT_V(8); PG8_WAIT_L(0); PG8_BAR; PG8_MMA(1, 0, At, B0); PG8_MMA(1, 1, At, B1); PG8_BAR; PG8_SCHED;
            } else {
            PG8_LDB(B0, 0, 0); PG8_SCHED; PG8_LDA(At, 0, 0); PG8_STAGE(PG8_SA(1, 1), a1 + hstepA, voffA);
            PG8_WAIT_L(8); PG8_BAR; PG8_WAIT_L(0); PG8_MMA(0, 0, At, B0); PG8_BAR; PG8_SCHED;
            PG8_LDB(B1, 0, 1); PG8_STAGE(PG8_SB(0, 0), b2, voffB);
            PG8_BAR; PG8_WAIT_L(0); PG8_MMA(0, 1, At, B1); PG8_BAR;
            PG8_LDA(At, 0, 1); PG8_STAGE(PG8_SA(0, 0), a2, voffA);
            PG8_BAR; PG8_WAIT_L(0); PG8_MMA(1, 0, At, B0); PG8_BAR; PG8_SCHED;
            PG8_STAGE(PG8_SB(0, 1), b2 + hstepB, voffB);
            PG8_WAIT_V(6); PG8_BAR; PG8_MMA(1, 1, At, B1); PG8_BAR;
            PG8_LDB(B0, 1, 0); PG8_SCHED; PG8_LDA(At, 1, 0); PG8_STAGE(PG8_SA(0, 1), a2 + hstepA, voffA);
            PG8_WAIT_L(8); PG8_BAR; PG8_WAIT_L(0); PG8_MMA(0, 0, At, B0); PG8_BAR; PG8_SCHED;
            PG8_LDB(B1, 1, 1); PG8_STAGE(PG8_SB(1, 0), b3, voffB);
            PG8_BAR; PG8_WAIT_L(0); PG8_MMA(0, 1, At, B1); PG8_BAR;
            PG8_LDA(At, 1, 1); PG8_STAGE(PG8_SA(1, 0), a3, voffA);
            PG8_BAR; PG8_WAIT_L(0); PG8_MMA(1, 0, At, B0); PG8_BAR; PG8_SCHED;
            PG8_STAGE(PG8_SB(1, 1), b3 + hstepB, voffB);
            PG8_WAIT_V(6); PG8_BAR; PG8_MMA(1, 1, At, B1); PG8_BAR;
            }
        }
        if constexpr (ALIGN_EPI) { if (wr == 0) PG8_BAR; }
        if constexpr (!Epi::AFTER_DRAIN) { E(acc, cur, wr, wc, fr, fq); S.done(cur); }
        if (!has_next) break;
#pragma unroll
        for (int a = 0; a < 2; ++a)
#pragma unroll
            for (int b = 0; b < 2; ++b)
#pragma unroll
                for (int m = 0; m < 4; ++m)
#pragma unroll
                    for (int n = 0; n < 2; ++n) acc[a][b][m][n] = (f32x4){0.f, 0.f, 0.f, 0.f};
        cur = nxt; cA = nA; cB = nB; ++ui;
        if constexpr (ALIGN_EPI) { if (wr == 1) PG8_BAR; }
    }
    PG8_WAIT_V(0);
    if constexpr (!ALIGN_EPI) { if (wr == 0) PG8_BAR; }
    PG8_BAR;
    if constexpr (Epi::AFTER_DRAIN) { E.fused(acc, cur, wr, wc, fr, fq, lds, wid, lane); S.done(cur); }
#undef PG8_SA
#undef PG8_SB
#undef PG8_STAGE
#undef PG8_LDA
#undef PG8_LDB
#undef PG8_MMA
#undef PG8_WAIT_V
#undef PG8_WAIT_L
#undef PG8_BAR
#undef PG8_SCHED
}
}
#define XB_TMO      128
#define XB_XCNT(j)  (256  + 64 * (j))
#define XB_XSUB(j)  (1280 + 64 * (j))
#define XB_XGEN(j)  (2304 + 64 * (j))
#define XB_TOP      3328
#define XB_TOPGEN   3392
#define XCD_BAR_WORDS 3456
#define XB_SPIN_CAP (1u << 20)
__device__ __forceinline__ unsigned xb_ld(unsigned* p)              { return __hip_atomic_load(p, __ATOMIC_RELAXED, __HIP_MEMORY_SCOPE_AGENT); }
__device__ __forceinline__ unsigned xb_add(unsigned* p, unsigned v) { return __hip_atomic_fetch_add(p, v, __ATOMIC_RELAXED, __HIP_MEMORY_SCOPE_AGENT); }
__device__ __forceinline__ unsigned xb_xcc_id() { return (unsigned)__builtin_amdgcn_s_getreg((3 << 11) | 20) & 0xFu; }
#define XB_SPIN(cond, bar) do { unsigned _sp = 0; while (cond) { __builtin_amdgcn_s_sleep(1); \
    if ((++_sp & 255u) == 0u) { if (xb_ld(&(bar)[XB_TMO])) break; if (_sp > XB_SPIN_CAP) { atomicAdd(&(bar)[XB_TMO], 1u); break; } } } } while (0)
struct XcdBarrier { unsigned* bar; unsigned x; volatile LAS unsigned* st; };
__device__ __forceinline__ XcdBarrier xcd_barrier_post(unsigned* bar, volatile LAS unsigned* st) {
    XcdBarrier b; b.bar = bar; b.x = xb_xcc_id(); b.st = st;
    if (threadIdx.x == 0) (void)xb_add(&bar[XB_XCNT(b.x)], 1u);
    return b;
}
__device__ __forceinline__ void xcd_barrier_complete(unsigned* bar, unsigned x, unsigned& nloc, unsigned& nx) {
    const unsigned G = gridDim.x * gridDim.y * gridDim.z;
    unsigned sum, cnt, mine, sp = 0u;
    for (;;) {
        sum = 0u; cnt = 0u; mine = 0u;
#pragma unroll
        for (unsigned j = 0; j < 16; ++j) { const unsigned c = xb_ld(&bar[XB_XCNT(j)]); sum += c; cnt += (c > 0u) ? 1u : 0u; mine = (j == x) ? c : mine; }
        if (sum == G) break;
        __builtin_amdgcn_s_sleep(1);
        if ((++sp & 255u) == 0u) { if (xb_ld(&bar[XB_TMO])) break; if (sp > XB_SPIN_CAP) { atomicAdd(&bar[XB_TMO], 1u); break; } }
    }
    nloc = mine > 0u ? mine : 1u; nx = cnt > 0u ? cnt : 1u;
}
__device__ __forceinline__ void xcd_barrier(const XcdBarrier& b) {
    asm volatile("s_waitcnt vmcnt(0)" ::: "memory");
    __syncthreads();
    if (threadIdx.x == 0) {
        unsigned* bar = b.bar;
        __builtin_amdgcn_s_waitcnt(0);
        unsigned nloc = b.st[0], nx = b.st[1];
        if (nloc == 0u) { xcd_barrier_complete(bar, b.x, nloc, nx); b.st[0] = nloc; b.st[1] = nx; }
        const unsigned old = xb_add(&bar[XB_XSUB(b.x)], 1u);
        const unsigned gen = old / nloc;
        if (old + 1u == (gen + 1u) * nloc) {
            __builtin_amdgcn_fence(__ATOMIC_RELEASE, "agent");
            asm volatile("s_waitcnt vmcnt(0)" ::: "memory");
            const unsigned og = xb_add(&bar[XB_TOP], 1u);
            const unsigned tg = og / nx;
            if (og + 1u == (tg + 1u) * nx) xb_add(&bar[XB_TOPGEN], 1u);
            else XB_SPIN(xb_ld(&bar[XB_TOPGEN]) == tg, bar);
            __builtin_amdgcn_fence(__ATOMIC_ACQUIRE, "agent");
            xb_add(&bar[XB_XGEN(b.x)], 1u);
            asm volatile("s_waitcnt vmcnt(0)" ::: "memory");
        } else {
            XB_SPIN(xb_ld(&bar[XB_XGEN(b.x)]) == gen, bar);
            __builtin_amdgcn_fence(__ATOMIC_ACQUIRE, "agent");
            asm volatile("s_waitcnt vmcnt(0)" ::: "memory");
        }
    }
    __syncthreads();
}

struct Args {
    const float* x; const float* mem; const float* norm_g; const float* w_in; const float* b_forget; const float* mem_norm_g; const float* w_mem_kv; const float* w_out; const float* final_g;
    float* out; unsigned char* ws; int ph_lo, ph_hi;
};

__device__ __forceinline__ void p0_transpose_item(const float* W, int ldw, int src_col0, int k0, bf16* WT, int K, int dst_row0, LAS float* scr, int lane) {
#pragma unroll 8
    for (int i = 0; i < 32; ++i) { const int kk = 2 * i + (lane >> 5); scr[kk * 33 + (lane & 31)] = W[(size_t)(k0 + kk) * ldw + src_col0 + (lane & 31)]; }
    LDS_WAIT(); asm volatile("" ::: "memory");
    const int c = lane & 7;
#pragma unroll
    for (int j = 0; j < 4; ++j) { const int n = (lane >> 3) + 8 * j; const LAS float* s = scr + (8 * c) * 33 + n;
        v4u o; o.x = pk2(s[0 * 33], s[1 * 33]); o.y = pk2(s[2 * 33], s[3 * 33]); o.z = pk2(s[4 * 33], s[5 * 33]); o.w = pk2(s[6 * 33], s[7 * 33]);
        *(GAS v4u*)(WT + (size_t)(dst_row0 + n) * K + k0 + 8 * c) = o; }
    LDS_WAIT(); asm volatile("" ::: "memory");
}
typedef float f32x4 __attribute__((ext_vector_type(4)));
__device__ __forceinline__ float log_sigmoid_f(float z) { return fminf(z, 0.f) - log1pf(expf(-fabsf(z))); }

__device__ __forceinline__ void sincos_small(double x, double& c, double& s) {
    const double k = __builtin_rint(x * 0.6366197723675814);
    double r = __builtin_fma(-k, 1.5707963267948966, x); r = __builtin_fma(-k, 6.123233995736766e-17, r);
    const double r2 = r * r;
    double sp = -7.647163731819816e-13;
    sp = __builtin_fma(sp, r2, 1.6059043836821613e-10);
    sp = __builtin_fma(sp, r2, -2.505210838544172e-08);
    sp = __builtin_fma(sp, r2, 2.7557319223985893e-06);
    sp = __builtin_fma(sp, r2, -0.0001984126984126984);
    sp = __builtin_fma(sp, r2, 0.008333333333333333);
    sp = __builtin_fma(sp, r2, -0.16666666666666666);
    const double sr = __builtin_fma(sp * r2, r, r);
    double cp = 4.779477332387385e-14;
    cp = __builtin_fma(cp, r2, -1.1470745597729725e-11);
    cp = __builtin_fma(cp, r2, 2.08767569878681e-09);
    cp = __builtin_fma(cp, r2, -2.755731922398589e-07);
    cp = __builtin_fma(cp, r2, 2.48015873015873e-05);
    cp = __builtin_fma(cp, r2, -0.001388888888888889);
    cp = __builtin_fma(cp, r2, 0.041666666666666664);
    cp = __builtin_fma(cp, r2, -0.5);
    const double cr = __builtin_fma(cp, r2, 1.0);
    const int q = (int)k & 3;
    c = (q == 0) ? cr : (q == 1) ? -sr : (q == 2) ? -cr : sr;
    s = (q == 0) ? sr : (q == 1) ? cr : (q == 2) ? -sr : -cr;
}
__device__ __forceinline__ void p0_prologue(const Args& a, LAS unsigned char* lds, int vcu, int G, int wave, int lane, int tid) {
    bf16* Win_t = (bf16*)(a.ws + WS_WIN); bf16* Wout_t = (bf16*)(a.ws + WS_WOUT); bf16* Wmkv_t = (bf16*)(a.ws + WS_WMKV);
    float* rope = (float*)(a.ws + WS_ROPE); float* logf_ = (float*)(a.ws + WS_LOGF);
    bf16* XN = (bf16*)((unsigned char*)a.out + DO_XN); bf16* MN = (bf16*)((unsigned char*)a.out + DO_MN);
    LAS float* scr = (LAS float*)(lds + RING_OFF + wave * 8704);
    LAS float* wf = (LAS float*)(lds + RING_OFF + 81920);
    const int gw = vcu * NWAVES + wave, NGW = G * NWAVES;
    for (int idx = tid; idx < 12 * 1024; idx += NWAVES * 64) { const int k = idx / 12, j = idx % 12; wf[j * 1024 + k] = a.w_in[(size_t)k * INW + S_FLOG + j]; }
    constexpr int I_IN = 16 * 224, I_OUT = 32 * 32, I_MKV = 16 * 32, NITEMS = I_IN + I_OUT + I_MKV;
    for (int it = gw; it < NITEMS; it += NGW) {
        int r = it;
        if (r < I_IN) { const int kb = r / 224, nb = r % 224; p0_transpose_item(a.w_in, INW, src_col_of_dst(32 * nb), 64 * kb, Win_t, 1024, 32 * nb, scr, lane); continue; } r -= I_IN;
        if (r < I_OUT) { const int kb = r / 32, nb = r % 32; p0_transpose_item(a.w_out, 1024, 32 * nb, 64 * kb, Wout_t, 2048, 32 * nb, scr, lane); continue; } r -= I_OUT;
        { const int kb = r / 32, nb = r % 32; p0_transpose_item(a.w_mem_kv, 1024, 32 * nb, 64 * kb, Wmkv_t, 1024, 32 * nb, scr, lane); }
    }
    for (int idx = gw * 64 + lane; idx < SEQ * 8; idx += NGW * 64) { const int pos = idx >> 3, i = idx & 7;
        const double invf = (i == 0) ? 1.0 : (i == 1) ? 0.19392274474868576 : (i == 2) ? 0.03760603093086393 : (i == 3) ? 0.007292664737217109 : (i == 4) ? 0.001414213562373095
                          : (i == 5) ? 0.0002742481756762073 : (i == 6) ? 5.318295896944988e-05 : 1.031338537721246e-05;
        double cv, sv; sincos_small((double)pos * invf, cv, sv); rope[2 * idx] = (float)cv; rope[2 * idx + 1] = (float)sv; }
    __syncthreads();
    f32x4 gv[4];
#pragma unroll
    for (int j = 0; j < 4; ++j) gv[j] = *(const f32x4*)(a.norm_g + 4 * lane + 256 * j);
    const float bfj = (lane < 12) ? a.b_forget[lane] : 0.f;
    for (int m = gw; m < M; m += NGW) {
        const GAS f32x4* xr = (const GAS f32x4*)(a.x + (size_t)m * DM) + lane;
        f32x4 v[4]; float s = 0.f;
#pragma unroll
        for (int j = 0; j < 4; ++j) { v[j] = xr[64 * j]; s += (v[j].x * v[j].x + v[j].y * v[j].y) + (v[j].z * v[j].z + v[j].w * v[j].w); }
        const float r = 1.0f / sqrtf(wave_sum(s) * (1.f / DM) + RMS_EPS);
#pragma unroll
        for (int j = 0; j < 4; ++j) v[j] = v[j] * r * gv[j];
        GAS unsigned long long* o8 = (GAS unsigned long long*)(XN + (size_t)m * DM) + lane;
#pragma unroll
        for (int j = 0; j < 4; ++j) o8[64 * j] = (unsigned long long)pk2(v[j].x, v[j].y) | ((unsigned long long)pk2(v[j].z, v[j].w) << 32);
        float mine = 0.f;
#pragma unroll 2
        for (int q = 0; q < 12; ++q) { float d = 0.f;
#pragma unroll
            for (int j = 0; j < 4; ++j) { const f32x4 w = *(const LAS f32x4*)(wf + q * 1024 + 256 * j + 4 * lane); d += (v[j].x * w.x + v[j].y * w.y) + (v[j].z * w.z + v[j].w * w.w); }
            d = wave_sum(d); if (lane == q) mine = d; }
        if (lane < 12) logf_[(size_t)m * 12 + lane] = log_sigmoid_f(mine + bfj);
    }
#pragma unroll
    for (int j = 0; j < 4; ++j) gv[j] = *(const f32x4*)(a.mem_norm_g + 4 * lane + 256 * j);
    for (int m = gw; m < MMEM; m += NGW) {
        const GAS f32x4* xr = (const GAS f32x4*)(a.mem + (size_t)m * DM) + lane;
        f32x4 v[4]; float s = 0.f;
#pragma unroll
        for (int j = 0; j < 4; ++j) { v[j] = xr[64 * j]; s += (v[j].x * v[j].x + v[j].y * v[j].y) + (v[j].z * v[j].z + v[j].w * v[j].w); }
        const float r = 1.0f / sqrtf(wave_sum(s) * (1.f / DM) + RMS_EPS);
#pragma unroll
        for (int j = 0; j < 4; ++j) v[j] = v[j] * r * gv[j];
        GAS unsigned long long* o8 = (GAS unsigned long long*)(MN + (size_t)m * DM) + lane;
#pragma unroll
        for (int j = 0; j < 4; ++j) o8[64 * j] = (unsigned long long)pk2(v[j].x, v[j].y) | ((unsigned long long)pk2(v[j].z, v[j].w) << 32);
    }
    __syncthreads();
}

__device__ __forceinline__ void fox_scan(const Args& a, int bh, int lane) {
    const float* logf_ = (const float*)(a.ws + WS_LOGF); v4u* kaug = (v4u*)(a.ws + WS_KAUG);
    const int b = bh / NH, h = bh % NH;
    float loc[32]; double tot = 0.0;
#pragma unroll
    for (int i = 0; i < 32; ++i) { loc[i] = logf_[((size_t)(b * SEQ + lane * 32 + i)) * 12 + h]; tot += (double)loc[i]; }
    double inc = tot;
#pragma unroll
    for (int o = 1; o < 64; o <<= 1) { const double t = __shfl_up(inc, o); if (lane >= o) inc += t; }
    double run = inc - tot;
#pragma unroll
    for (int i = 0; i < 32; ++i) { run += (double)loc[i]; const float x = -(float)(run * 1.4426950408889634);
        const unsigned hi = f2bf(x); const float r1 = x - __uint_as_float(hi << 16); const unsigned mi = f2bf(r1); const float r2 = r1 - __uint_as_float(mi << 16); const unsigned lo = f2bf(r2);
        v4u o; o.x = hi | (mi << 16); o.y = lo | (0x3f80u << 16); o.z = 0x3f80u | (0x3f80u << 16); o.w = 0u;
        kaug[(size_t)bh * SEQ + lane * 32 + i] = o; }
}

__device__ __forceinline__ void final_norm(const Args& a, int vcu, int G, int wave, int lane) {
    const float* ssq = (const float*)(a.ws + WS_SSQ);
    const int gw = vcu * NWAVES + wave, NGW = G * NWAVES;
    f32x4 gv[4];
#pragma unroll
    for (int j = 0; j < 4; ++j) gv[j] = *(const f32x4*)(a.final_g + 4 * lane + 256 * j);
    for (int m = gw; m < M; m += NGW) {
        float s = (lane < 16) ? ssq[(size_t)m * 16 + lane] : 0.f;
        s += __shfl_xor(s, 1); s += __shfl_xor(s, 2); s += __shfl_xor(s, 4); s += __shfl_xor(s, 8);
        s = __shfl(s, 0);
        const float r = 1.0f / sqrtf(s * (1.f / DM) + RMS_EPS);
        GAS f32x4* xr = (GAS f32x4*)(a.out + (size_t)m * DM) + lane;
#pragma unroll
        for (int j = 0; j < 4; ++j) { f32x4 v = xr[64 * j]; v = v * r * gv[j]; xr[64 * j] = v; }
    }
}
__device__ __forceinline__ void ld_row64(const bf16* p, float* f) {
    const v4u* q = (const v4u*)p;
#pragma unroll
    for (int i = 0; i < 8; ++i) { const v4u u = q[i]; f[8 * i + 0] = bflo(u.x); f[8 * i + 1] = bfhi(u.x); f[8 * i + 2] = bflo(u.y); f[8 * i + 3] = bfhi(u.y);
        f[8 * i + 4] = bflo(u.z); f[8 * i + 5] = bfhi(u.z); f[8 * i + 6] = bflo(u.w); f[8 * i + 7] = bfhi(u.w); }
}
__device__ __forceinline__ void st_row64_gated(bf16* dst, const bf16* gate, const float* o, float inv) {
    v4u* d = (v4u*)dst; const v4u* g = (const v4u*)gate;
#pragma unroll
    for (int i = 0; i < 8; ++i) { const v4u u = g[i]; v4u w;
        w.x = pk2(o[8 * i + 0] * inv * bflo(u.x), o[8 * i + 1] * inv * bfhi(u.x)); w.y = pk2(o[8 * i + 2] * inv * bflo(u.y), o[8 * i + 3] * inv * bfhi(u.y));
        w.z = pk2(o[8 * i + 4] * inv * bflo(u.z), o[8 * i + 5] * inv * bfhi(u.z)); w.w = pk2(o[8 * i + 6] * inv * bflo(u.w), o[8 * i + 7] * inv * bfhi(u.w)); d[i] = w; }
}
__device__ __forceinline__ float kaug_c(const v4u u) { return -((bflo(u.x) + bfhi(u.x)) + bflo(u.y)); }

__global__ void __launch_bounds__(256) fox_naive(unsigned char* ws) {
    bf16* P = (bf16*)(ws + WS_PROJ); const v4u* kaug = (const v4u*)(ws + WS_KAUG);
    const int blk = blockIdx.x, qb = blk % 8, bh = blk / 8, b = bh / NH, h = bh % NH;
    const int t = qb * 256 + threadIdx.x; const size_t row = (size_t)b * SEQ + t;
    float q[64], o[64], kv[64];
    ld_row64(P + row * NPROJ + C_FQ + h * 64, q);
#pragma unroll
    for (int d = 0; d < 64; ++d) o[d] = 0.f;
    const float cq = kaug_c(kaug[(size_t)bh * SEQ + t]);
    float m = -1e30f, l = 0.f;
    const int kend = qb * 256 + 256;
    for (int k = 0; k < kend; ++k) {
        const size_t krow = (size_t)b * SEQ + k;
        ld_row64(P + krow * NPROJ + C_FK + h * 64, kv);
        float s = 0.f;
#pragma unroll
        for (int d = 0; d < 64; ++d) s += q[d] * kv[d];
        s += cq - kaug_c(kaug[(size_t)bh * SEQ + k]);
        ld_row64(P + krow * NPROJ + C_FV + h * 64, kv);
        if (k <= t) {
            const float mn = fmaxf(m, s), al = exp2f(m - mn), p = exp2f(s - mn);
            l = l * al + p; m = mn;
#pragma unroll
            for (int d = 0; d < 64; ++d) o[d] = o[d] * al + p * kv[d];
        }
    }
    st_row64_gated(P + row * NPROJ + C_FQ + h * 64, P + row * NPROJ + C_FG + h * 64, o, 1.0f / l);
}

__global__ void __launch_bounds__(256) dil_naive(unsigned char* ws) {
    bf16* P = (bf16*)(ws + WS_PROJ);
    const int blk = blockIdx.x, qb = blk % 8, bh = blk / 8, b = bh / NH, h = bh % NH;
    const int t = qb * 256 + threadIdx.x; const size_t row = (size_t)b * SEQ + t;
    float q[64], o[64], kv[64];
    ld_row64(P + row * NPROJ + C_DQ + h * 64, q);
#pragma unroll
    for (int d = 0; d < 64; ++d) o[d] = 0.f;
    float m = -1e30f, l = 0.f;
    for (int pat = 0; pat < 3; ++pat) {
        const int dil = (pat == 0) ? 1 : (pat == 1) ? 4 : 16;
        for (int j = 0; j <= 128; ++j) {
            const int k = t - j * dil;
            if (k >= 0) {
                const size_t krow = (size_t)b * SEQ + k;
                ld_row64(P + krow * NPROJ + C_DK + h * 64, kv);
                float s = 0.f;
#pragma unroll
                for (int d = 0; d < 64; ++d) s += q[d] * kv[d];
                ld_row64(P + krow * NPROJ + C_DV + h * 64, kv);
                const float mn = fmaxf(m, s), al = exp2f(m - mn), p = exp2f(s - mn);
                l = l * al + p; m = mn;
#pragma unroll
                for (int d = 0; d < 64; ++d) o[d] = o[d] * al + p * kv[d];
            }
        }
    }
    st_row64_gated(P + row * NPROJ + C_DQ + h * 64, P + row * NPROJ + C_DG + h * 64, o, 1.0f / l);
}

__global__ void __launch_bounds__(256) mem_naive(unsigned char* ws, const unsigned char* dout) {
    bf16* P = (bf16*)(ws + WS_PROJ); const bf16* MKV = (const bf16*)(dout + DO_MKV);
    const int gid = blockIdx.x * 256 + threadIdx.x, half = gid & 1, qi = gid >> 1;
    const int t = qi % SEQ, bm = qi / SEQ, mh = bm % MH, b = bm / MH; const size_t row = (size_t)b * SEQ + t;
    float q[64], o[64], kv[64];
    ld_row64(P + row * NPROJ + C_MQ + mh * 128 + half * 64, q);
#pragma unroll
    for (int d = 0; d < 64; ++d) o[d] = 0.f;
    float m = -1e30f, l = 0.f;
    for (int k = 0; k < MEMLEN; ++k) {
        const size_t krow = (size_t)b * MEMLEN + k;
        ld_row64(MKV + krow * 1024 + mh * 128 + half * 64, kv);
        float s = 0.f;
#pragma unroll
        for (int d = 0; d < 64; ++d) s += q[d] * kv[d];
        s += __shfl_xor(s, 1);
        ld_row64(MKV + krow * 1024 + 512 + mh * 128 + half * 64, kv);
        const float mn = fmaxf(m, s), al = exp2f(m - mn), p = exp2f(s - mn);
        l = l * al + p; m = mn;
#pragma unroll
        for (int d = 0; d < 64; ++d) o[d] = o[d] * al + p * kv[d];
    }
    st_row64_gated(P + row * NPROJ + C_MQ + mh * 128 + half * 64, P + row * NPROJ + C_MG + mh * 128 + half * 64, o, 1.0f / l);
}
__global__ void __launch_bounds__(NWAVES * 64, 2) fwd(Args args) {
    extern __shared__ __attribute__((aligned(16))) unsigned char lds_raw[];
    LAS unsigned char* lds = (LAS unsigned char*)lds_raw;
    volatile LAS unsigned* MISC = (volatile LAS unsigned*)(lds + MISC_OFF);
    const int tid = threadIdx.x, lane = tid & 63, wave = __builtin_amdgcn_readfirstlane(tid >> 6);
    const int G = gridDim.x; const int bx = blockIdx.x; const int vcu = (G % 8 == 0) ? (bx % 8) * (G / 8) + bx / 8 : bx;
    gu32* ctl = (gu32*)(args.ws + WS_CTL);
    for (int u = tid; u < (LDS_BYTES - LDSCTL_OFF) / 4; u += NWAVES * 64) ((LAS unsigned*)(lds + LDSCTL_OFF))[u] = 0u;
    __syncthreads();
    const int lo = args.ph_lo, hi = args.ph_hi;
    const bool multi = (hi - lo) > 1;
    XcdBarrier bar; bar.bar = (unsigned*)(ctl + CW_BAR); bar.x = 0; bar.st = nullptr;
    if (multi) bar = xcd_barrier_post((unsigned*)(ctl + CW_BAR), MISC + 8);
#define IN(k) (lo <= (k) && (k) < hi)
#define BOTH(k) (IN(k) && IN((k) + 1))
#define GRID_BAR() xcd_barrier(bar)

    bf16* Win_t = (bf16*)(args.ws + WS_WIN); bf16* Wout_t = (bf16*)(args.ws + WS_WOUT); bf16* Wmkv_t = (bf16*)(args.ws + WS_WMKV);
    bf16* PROJ = (bf16*)(args.ws + WS_PROJ);
    bf16* XN = (bf16*)((unsigned char*)args.out + DO_XN); bf16* MN = (bf16*)((unsigned char*)args.out + DO_MN); bf16* MKV = (bf16*)((unsigned char*)args.out + DO_MKV);

    if (IN(0)) { p0_prologue(args, lds, vcu, G, wave, lane, tid); if (BOTH(0)) GRID_BAR(); }

    if (IN(1)) {
        if (wave == 0) for (int bh = bx; bh < BATCH * NH; bh += G) fox_scan(args, bh, lane);
        { pg8::Gemm g{XN, Win_t, M, NPROJ, DM, DM}; pg8::StaticOrder S; S.init(M, NPROJ, G, bx);
          pg8::EpiProj E{PROJ, NPROJ, (const float*)(args.ws + WS_ROPE), C2, C2M};
          pg8::gemm_phase<pg8::EpiProj, pg8::StaticOrder, true, true>(lds + RING_OFF, g, S, E); }
        { pg8::Gemm g{MN, Wmkv_t, MMEM, 1024, DM, DM}; pg8::StaticOrder S; S.init(MMEM, 1024, G, (bx + G / 2) % G);
          pg8::EpiPlain E{MKV, 1024};
          pg8::gemm_phase<pg8::EpiPlain, pg8::StaticOrder, true, true>(lds + RING_OFF, g, S, E); }
        if (BOTH(1)) GRID_BAR();
    }

    if (IN(2)) { if (BOTH(2)) GRID_BAR(); }

    if (IN(3)) {
        pg8::Gemm g{PROJ, Wout_t, M, DM, 2048, NPROJ}; pg8::StaticOrder S; S.init(M, DM, G, bx);
        pg8::EpiRes E{args.x, args.out, DM, (float*)(args.ws + WS_SSQ)};
        pg8::gemm_phase<pg8::EpiRes, pg8::StaticOrder, true, true>(lds + RING_OFF, g, S, E);
        if (BOTH(3)) GRID_BAR();
    }

    if (IN(4)) final_norm(args, vcu, G, wave, lane);
#undef IN
#undef BOTH
#undef GRID_BAR
}

extern "C" void kernel_launch(void* const* d_in, const int* in_sizes, int n_in, void* d_out, int out_size, void* d_ws, size_t ws_size, hipStream_t stream) {
    static int grid = 0;
    if (grid == 0) {
        if (n_in != 9 || in_sizes[0] != M * DM || out_size != M * DM || ws_size < WS_END) { fprintf(stderr, "kernel_launch: unexpected shapes (n_in %d, in0 %d, out %d, ws %zu)\n", n_in, n_in > 0 ? in_sizes[0] : -1, out_size, ws_size); grid = -1; return; }
        int dev = 0, cus = 0;
        if (hipGetDevice(&dev) != hipSuccess || hipDeviceGetAttribute(&cus, hipDeviceAttributeMultiprocessorCount, dev) != hipSuccess) { grid = -1; return; }
        if (hipFuncSetAttribute((const void*)fwd, hipFuncAttributeMaxDynamicSharedMemorySize, LDS_BYTES) != hipSuccess) { fprintf(stderr, "kernel_launch: hipFuncSetAttribute failed\n"); grid = -1; return; }
        int per_cu = 0;
        if (hipOccupancyMaxActiveBlocksPerMultiprocessor(&per_cu, (const void*)fwd, NWAVES * 64, LDS_BYTES) != hipSuccess || per_cu < 1) fprintf(stderr, "kernel_launch: occupancy query says %d\n", per_cu);
        (void)hipGetLastError();
        grid = cus;
    }
    if (grid < 0) return;
    (void)hipMemsetAsync((char*)d_ws + WS_CTL, 0, CTL_ZERO_BYTES, stream);
    Args a{};
    a.x = (const float*)d_in[0]; a.mem = (const float*)d_in[1]; a.norm_g = (const float*)d_in[2]; a.w_in = (const float*)d_in[3]; a.b_forget = (const float*)d_in[4];
    a.mem_norm_g = (const float*)d_in[5]; a.w_mem_kv = (const float*)d_in[6]; a.w_out = (const float*)d_in[7]; a.final_g = (const float*)d_in[8];
    a.out = (float*)d_out; a.ws = (unsigned char*)d_ws;
#if N_LAUNCH_MODE == 0
    a.ph_lo = 0; a.ph_hi = 1; hipLaunchKernelGGL(fwd, dim3(grid), dim3(NWAVES * 64), LDS_BYTES, stream, a);
    a.ph_lo = 1; a.ph_hi = 2; hipLaunchKernelGGL(fwd, dim3(grid), dim3(NWAVES * 64), LDS_BYTES, stream, a);
    hipLaunchKernelGGL(fox_naive, dim3(BATCH * NH * 8), dim3(256), 0, stream, (unsigned char*)d_ws);
    hipLaunchKernelGGL(dil_naive, dim3(BATCH * NH * 8), dim3(256), 0, stream, (unsigned char*)d_ws);
    hipLaunchKernelGGL(mem_naive, dim3(BATCH * MH * SEQ * 2 / 256), dim3(256), 0, stream, (unsigned char*)d_ws, (const unsigned char*)d_out);
    a.ph_lo = 3; a.ph_hi = 4; hipLaunchKernelGGL(fwd, dim3(grid), dim3(NWAVES * 64), LDS_BYTES, stream, a);
    a.ph_lo = 4; a.ph_hi = 5; hipLaunchKernelGGL(fwd, dim3(grid), dim3(NWAVES * 64), LDS_BYTES, stream, a);
#else
    a.ph_lo = 0; a.ph_hi = 5; hipLaunchKernelGGL(fwd, dim3(grid), dim3(NWAVES * 64), LDS_BYTES, stream, a);
#endif
}
```

```cpp
#include <hip/hip_runtime.h>
#include <hip/hip_bf16.h>
#include <cstdio>
#include <cstdint>
#include <cmath>

constexpr int BATCH = 16, SEQ = 2048, DM = 1024, M = BATCH * SEQ;
constexpr int INW = 7180, NPROJ = 7168;
constexpr int MEMLEN = 256, MMEM = BATCH * MEMLEN;
constexpr int NH = 12, HD = 64, MH = 4, MHD = 128;
constexpr float RMS_EPS = 1e-6f;
constexpr float LOG2E = 1.4426950408889634f;
constexpr float C2 = 0.125f * LOG2E;
constexpr float C2M = 0.08838834764831845f * LOG2E;
constexpr int C_FQ = 0, C_DQ = 768, C_MQ = 1536, C_FK = 2048, C_FV = 2816, C_FG = 3584, C_DK = 4352, C_DV = 5120, C_DG = 5888, C_MG = 6656;
constexpr int S_FQ = 0, S_FK = 768, S_FV = 1536, S_FG = 2304, S_FLOG = 3072, S_DQ = 3084, S_DK = 3852, S_DV = 4620, S_DG = 5388, S_MQ = 6156, S_MG = 6668;
__host__ __device__ __forceinline__ int src_col_of_dst(int d) {
    if (d < 768) return S_FQ + d;
    if (d < 1536) return S_DQ + d - 768;
    if (d < 2048) return S_MQ + d - 1536;
    if (d < 2816) return S_FK + d - 2048;
    if (d < 3584) return S_FV + d - 2816;
    if (d < 4352) return S_FG + d - 3584;
    if (d < 5120) return S_DK + d - 4352;
    if (d < 5888) return S_DV + d - 5120;
    if (d < 6656) return S_DG + d - 5888;
    return S_MG + d - 6656;
}

constexpr size_t MiB = 1u << 20;
constexpr size_t WS_CTL = 0, CTL_ZERO_BYTES = 1 * MiB;
constexpr size_t WS_WIN = 2 * MiB;
constexpr size_t WS_WOUT = 16 * MiB;
constexpr size_t WS_WMKV = 20 * MiB;
constexpr size_t WS_ROPE = 22 * MiB;
constexpr size_t WS_LOGF = 23 * MiB;
constexpr size_t WS_KAUG = 25 * MiB;
constexpr size_t WS_SSQ = 31 * MiB;
constexpr size_t WS_PROJ = 34 * MiB;
constexpr size_t WS_END = WS_PROJ + (size_t)M * NPROJ * 2;
constexpr size_t DO_XN = 0;
constexpr size_t DO_MN = 64 * MiB;
constexpr size_t DO_MKV = 72 * MiB;
constexpr int CW_TMO = 0, CW_CODE = 1, CW_QUEUE = 64, CW_BAR = 4096;

constexpr int NWAVES = 8;
constexpr int RING_OFF = 0, RING_BYTES = 131072;
constexpr int LDSCTL_OFF = RING_BYTES, MISC_OFF = LDSCTL_OFF + 320;
constexpr int LDS_BYTES = 147456;

#define GAS __attribute__((address_space(1)))
#define LAS __attribute__((address_space(3)))
typedef unsigned short bf16;
typedef unsigned v4u __attribute__((ext_vector_type(4)));
typedef GAS unsigned gu32;
#define RLX_AGENT __ATOMIC_RELAXED, __HIP_MEMORY_SCOPE_AGENT
#define LDS_WAIT() asm volatile("s_waitcnt lgkmcnt(0)" ::: "memory")
#define VM_WAIT() asm volatile("s_waitcnt vmcnt(0)" ::: "memory")
__device__ __forceinline__ unsigned f2bf(float f) { unsigned u = __builtin_bit_cast(unsigned, f); return (u + 0x7fffu + ((u >> 16) & 1u)) >> 16; }
__device__ __forceinline__ unsigned pk2(float lo, float hi) { return f2bf(lo) | (f2bf(hi) << 16); }
__device__ __forceinline__ float bflo(unsigned u) { return __uint_as_float(u << 16); }
__device__ __forceinline__ float bfhi(unsigned u) { return __uint_as_float(u & 0xffff0000u); }
__device__ __forceinline__ float wave_sum(float v) {
#pragma unroll
    for (int o = 1; o < 64; o <<= 1) v += __shfl_xor(v, o);
    return v;
}

#ifndef N_LAUNCH_MODE
#define N_LAUNCH_MODE 1
#endif
namespace pg8 {
#define PG8_LAS __attribute__((address_space(3)))
typedef unsigned short bf16_t;
typedef short bf16x8 __attribute__((ext_vector_type(8)));
typedef float f32x4 __attribute__((ext_vector_type(4)));
typedef unsigned u32x4 __attribute__((ext_vector_type(4)));
constexpr int BM = 256, BK = 64, HALF = 128, HTB = HALF * BK * 2  , STAGE_BYTES = 8 * HTB, NXCD = 8, WGM = 8;

__host__ __device__ __forceinline__ int lds_byte(int r, int c) { const int st = (r >> 4) * 2 + (c >> 5), rr = r & 15, cc = c & 31, ob = rr * 64 + cc * 2; return st * 1024 + (ob ^ (((ob >> 9) & 1) << 5)); }
__host__ __device__ __forceinline__ void stage_rc(int b, int& R, int& C) { const int st = b / 1024, sb = b % 1024, swz = sb ^ (((sb >> 9) & 1) << 5); R = (st >> 1) * 16 + swz / 64; C = (st & 1) * 32 + (swz % 64) / 2; }
__host__ __device__ __forceinline__ int perm32(int rho) { const int n = rho >> 4, i = rho & 15; return 8 * (i >> 2) + 4 * n + (i & 3); }

struct Unit { int pm, pn; };
struct Gemm { const bf16_t* A; const bf16_t* Bt; int M, N, K, lda; };

struct StaticOrder {
    int nM, nN, nwg, G, c;
    __host__ __device__ void init(int M, int N, int G_, int c_) { nM = M / BM; nN = N / BM; nwg = nM * nN; G = G_; c = c_; }
    __host__ __device__ bool next(int i, Unit& u) const {
        const long L = (long)i * G + c; if (L >= nwg) return false;
        int wgid = (int)L; { const int q = nwg / NXCD, r = nwg % NXCD, xcd = wgid % NXCD, off = wgid / NXCD; wgid = (xcd < r ? xcd * (q + 1) : r * (q + 1) + (xcd - r) * q) + off; }
        const int nig = WGM * nN, gid = wgid / nig, fm = gid * WGM, gsz = (nM - fm) < WGM ? (nM - fm) : WGM;
        u.pm = fm + ((wgid % nig) % gsz); u.pn = (wgid % nig) / gsz; return true;
    }
    __device__ __forceinline__ void a_ready(const Unit&) const {}
    __device__ __forceinline__ void done(const Unit&) const {}
};

__device__ __forceinline__ unsigned cvt_pk_bf16(float lo, float hi) { unsigned r; asm volatile("v_cvt_pk_bf16_f32 %0, %1, %2" : "=v"(r) : "v"(lo), "v"(hi)); return r; }
__device__ __forceinline__ float silu_f(float v) { return v * __builtin_amdgcn_rcpf(1.0f + __builtin_amdgcn_exp2f(-1.4426950408889634f * v)); }

struct EpiPlain {
    static constexpr bool PERM = true, AFTER_DRAIN = false;
    bf16_t* O; int ldc;
    __device__ __forceinline__ void operator()(const f32x4 (&acc)[2][2][4][2], const Unit& u, int wr, int wc, int fr, int fq) const {
        const int row0 = u.pm * BM + wr * 64 + fr, col0 = u.pn * BM + wc * 32 + 8 * fq;
#pragma unroll
        for (int ai = 0; ai < 2; ++ai)
#pragma unroll
            for (int m = 0; m < 4; ++m) { bf16_t* rowp = O + (size_t)(row0 + ai * HALF + m * 16) * ldc + col0;
#pragma unroll
                for (int bj = 0; bj < 2; ++bj) { const f32x4 v0 = acc[ai][bj][m][0], v1 = acc[ai][bj][m][1];
                    u32x4 w; w.x = cvt_pk_bf16(v0[0], v0[1]); w.y = cvt_pk_bf16(v0[2], v0[3]); w.z = cvt_pk_bf16(v1[0], v1[1]); w.w = cvt_pk_bf16(v1[2], v1[3]);
                    *(u32x4*)(rowp + bj * HALF) = w; } }
    }
};

struct EpiProj {
    static constexpr bool PERM = true, AFTER_DRAIN = false;
    bf16_t* O; int ldc; const float* rope;
    float c2, c2m;
    __device__ __forceinline__ void operator()(const f32x4 (&acc)[2][2][4][2], const Unit& u, int wr, int wc, int fr, int fq) const {
        const int pn = u.pn;
        int kind; float sc = 1.f;
        if (pn < 3) { kind = 1; sc = c2; } else if (pn < 6) { kind = 2; sc = c2; } else if (pn < 8) { kind = 1; sc = c2m; } else if (pn < 14) kind = 0;
        else if (pn < 17) kind = 4; else if (pn < 20) kind = 3; else if (pn < 23) kind = 0; else kind = 4;
        const bool do_rope = (kind == 2 || kind == 3) && ((wc & 1) == 0);
        const int row0 = u.pm * BM + wr * 64 + fr, col0 = pn * BM + wc * 32 + 8 * fq;
#pragma unroll
        for (int ai = 0; ai < 2; ++ai)
#pragma unroll
            for (int m = 0; m < 4; ++m) { const int row = row0 + ai * HALF + m * 16; bf16_t* rowp = O + (size_t)row * ldc + col0;
                f32x4 cs[4];
                if (do_rope) { const f32x4* rp = (const f32x4*)(rope + (size_t)(row & 2047) * 16);
#pragma unroll
                    for (int i = 0; i < 4; ++i) cs[i] = rp[i]; }
#pragma unroll
                for (int bj = 0; bj < 2; ++bj) { f32x4 v0 = acc[ai][bj][m][0], v1 = acc[ai][bj][m][1];
                    if (do_rope) {
                        float p[8], v[8] = {v0[0], v0[1], v0[2], v0[3], v1[0], v1[1], v1[2], v1[3]};
#pragma unroll
                        for (int e = 0; e < 8; ++e) p[e] = __shfl_xor(v[e], 16);
                        const float sg = (fq == 0) ? -1.f : 1.f;
#pragma unroll
                        for (int e = 0; e < 8; ++e) { const float c = cs[e >> 1][(e & 1) * 2], s = cs[e >> 1][(e & 1) * 2 + 1]; const float r = v[e] * c + sg * p[e] * s; if (fq < 2) v[e] = r; }
                        v0 = (f32x4){v[0], v[1], v[2], v[3]}; v1 = (f32x4){v[4], v[5], v[6], v[7]};
                    }
                    if (kind == 4) {
#pragma unroll
                        for (int e = 0; e < 4; ++e) { v0[e] = silu_f(v0[e]); v1[e] = silu_f(v1[e]); }
                    }
                    v0 = v0 * sc; v1 = v1 * sc;
                    u32x4 w; w.x = cvt_pk_bf16(v0[0], v0[1]); w.y = cvt_pk_bf16(v0[2], v0[3]); w.z = cvt_pk_bf16(v1[0], v1[1]); w.w = cvt_pk_bf16(v1[2], v1[3]);
                    *(u32x4*)(rowp + bj * HALF) = w; } }
    }
};

struct EpiRes {
    static constexpr bool PERM = false, AFTER_DRAIN = false;
    const float* base; float* out; int ldc; float* ssq;
    __device__ __forceinline__ void operator()(const f32x4 (&acc)[2][2][4][2], const Unit& u, int wr, int wc, int fr, int fq) const {
        const int col0 = u.pn * BM + wc * 32 + 4 * fq;
#pragma unroll
        for (int ai = 0; ai < 2; ++ai)
#pragma unroll
            for (int m = 0; m < 4; ++m) { const int row = u.pm * BM + ai * HALF + wr * 64 + m * 16 + fr; const size_t off = (size_t)row * ldc + col0; float s = 0.f;
#pragma unroll
                for (int bj = 0; bj < 2; ++bj)
#pragma unroll
                    for (int n = 0; n < 2; ++n) { const f32x4 bs = *(const f32x4*)(base + off + bj * HALF + n * 16); const f32x4 o = bs + acc[ai][bj][m][n];
                        *(f32x4*)(out + off + bj * HALF + n * 16) = o; s += (o[0] * o[0] + o[1] * o[1]) + (o[2] * o[2] + o[3] * o[3]); }
                s += __shfl_xor(s, 16); s += __shfl_xor(s, 32);
                if (fq == 0) ssq[(size_t)row * 16 + u.pn * 4 + wc] = s; }
    }
};

template <class Epi, class Sched, bool ALIGN_EPI = false, bool SP2 = false>
__device__ __forceinline__ void gemm_phase(PG8_LAS unsigned char* lds, const Gemm g, const Sched& S, const Epi& E) {
    const int tid = threadIdx.x, wid = __builtin_amdgcn_readfirstlane(tid >> 6), lane = tid & 63, wr = wid >> 2, wc = wid & 3, fr = lane & 15, fq = lane >> 4;
    const int K = g.K, nt = K / BK;
    unsigned voffA[2], voffB[2];
#pragma unroll
    for (int i = 0; i < 2; ++i) { int R, C; stage_rc(tid * 16 + i * 8192, R, C); const int Rb = Epi::PERM ? ((R & ~31) + perm32(R & 31)) : R;
        voffA[i] = (unsigned)(R * g.lda + C) * 2u; voffB[i] = (unsigned)(Rb * K + C) * 2u; }
    const size_t kstep = (size_t)(BK * 2);
    const size_t hstepA = (size_t)HALF * g.lda * 2, hstepB = (size_t)HALF * K * 2;
    const size_t tstepA = 2 * hstepA, tstepB = 2 * hstepB;
    const unsigned ldsw = (unsigned)wid * 1024u;
    const int aoff = lds_byte(wr * 64 + fr, fq * 8), boff = lds_byte(wc * 32 + fr, fq * 8);
#define PG8_SA(b, h) (((b) * 2 + (h)) * HTB)
#define PG8_SB(b, h) ((4 + (b) * 2 + (h)) * HTB)
#define PG8_STAGE(bufoff, gbase, voff) do { _Pragma("unroll") for (int _i = 0; _i < 2; ++_i) \
        __builtin_amdgcn_global_load_lds((const unsigned*)((const char*)(gbase) + (voff)[_i]), (PG8_LAS unsigned*)(lds + (bufoff) + ldsw + _i * 8192), 16, 0, 0); } while (0)
#define PG8_LDA(dst, b, h) do { _Pragma("unroll") for (int m = 0; m < 4; ++m) _Pragma("unroll") for (int k = 0; k < 2; ++k) dst[m][k] = *(const PG8_LAS bf16x8*)(lds + PG8_SA(b, h) + aoff + m * 2048 + k * 1024); } while (0)
#define PG8_LDB(dst, b, h) do { _Pragma("unroll") for (int n = 0; n < 2; ++n) _Pragma("unroll") for (int k = 0; k < 2; ++k) dst[n][k] = *(const PG8_LAS bf16x8*)(lds + PG8_SB(b, h) + boff + n * 2048 + k * 1024); } while (0)
#define PG8_MMA(ai, bj, At, Bt) do { __builtin_amdgcn_s_setprio(1); _Pragma("unroll") for (int m = 0; m < 4; ++m) _Pragma("unroll") for (int n = 0; n < 2; ++n) _Pragma("unroll") for (int k = 0; k < 2; ++k) \
        acc[ai][bj][m][n] = __builtin_amdgcn_mfma_f32_16x16x32_bf16(Bt[n][k], At[m][k], acc[ai][bj][m][n], 0, 0, 0); __builtin_amdgcn_s_setprio(0); } while (0)
#define PG8_WAIT_V(n) asm volatile("s_waitcnt vmcnt(" #n ")" ::: "memory")
#define PG8_WAIT_L(n) asm volatile("s_waitcnt lgkmcnt(" #n ")" ::: "memory")
#define PG8_BAR __builtin_amdgcn_s_barrier()
#define PG8_SCHED __builtin_amdgcn_sched_barrier(0)
    Unit cur, nxt; int ui = 0;
    if (!S.next(0, cur)) return;
    f32x4 acc[2][2][4][2];
#pragma unroll
    for (int a = 0; a < 2; ++a)
#pragma unroll
        for (int b = 0; b < 2; ++b)
#pragma unroll
            for (int m = 0; m < 4; ++m)
#pragma unroll
                for (int n = 0; n < 2; ++n) acc[a][b][m][n] = (f32x4){0.f, 0.f, 0.f, 0.f};
    bf16x8 At[4][2], B0[2][2], B1[2][2];
    const char* cA = (const char*)g.A + (size_t)cur.pm * tstepA; const char* cB = (const char*)g.Bt + (size_t)cur.pn * tstepB;
    S.a_ready(cur);
    if constexpr (SP2) {
        PG8_STAGE(PG8_SB(0, 0), cB, voffB); PG8_STAGE(PG8_SB(0, 1), cB + hstepB, voffB); PG8_STAGE(PG8_SA(0, 0), cA, voffA); PG8_STAGE(PG8_SA(0, 1), cA + hstepA, voffA);
        if (wr == 1) PG8_BAR;
        PG8_WAIT_V(2); PG8_BAR;
        PG8_STAGE(PG8_SB(1, 0), cB + kstep, voffB); PG8_STAGE(PG8_SA(1, 0), cA + kstep, voffA); PG8_STAGE(PG8_SB(1, 1), cB + hstepB + kstep, voffB);
        PG8_WAIT_V(6); PG8_BAR;
    } else {
        PG8_STAGE(PG8_SB(0, 0), cB, voffB); PG8_STAGE(PG8_SA(0, 0), cA, voffA); PG8_STAGE(PG8_SB(0, 1), cB + hstepB, voffB); PG8_STAGE(PG8_SA(0, 1), cA + hstepA, voffA);
        if (wr == 1) PG8_BAR;
        PG8_WAIT_V(4); PG8_BAR;
        PG8_STAGE(PG8_SB(1, 0), cB + kstep, voffB); PG8_STAGE(PG8_SA(1, 0), cA + kstep, voffA); PG8_STAGE(PG8_SB(1, 1), cB + hstepB + kstep, voffB);
        PG8_WAIT_V(6); PG8_BAR;
    }
    for (;;) {
        const bool has_next = S.next(ui + 1, nxt);
        const char* nA = has_next ? (const char*)g.A + (size_t)nxt.pm * tstepA : cA; const char* nB = has_next ? (const char*)g.Bt + (size_t)nxt.pn * tstepB : cB;
        for (int t = 0; t < nt; t += 2) {
            const bool last = (t == nt - 2);
            const char* a1 = cA + (size_t)(t + 1) * kstep;
            const char* a2 = last ? nA : cA + (size_t)(t + 2) * kstep; const char* b2 = last ? nB : cB + (size_t)(t + 2) * kstep;
            const char* a3 = a2 + kstep; const char* b3 = b2 + kstep;
            if (last && has_next) S.a_ready(nxt);
            if constexpr (SP2) {
            PG8_LDB(B0, 0, 0); PG8_LDB(B1, 0, 1); PG8_SCHED; PG8_LDA(At, 0, 0); PG8_STAGE(PG8_SA(1, 1), a1 + hstepA, voffA);
            PG8_WAIT_V(8); PG8_WAIT_L(0); PG8_BAR; PG8_MMA(0, 0, At, B0); PG8_MMA(0, 1, At, B1); PG8_BAR; PG8_SCHED;
            PG8_LDA(At, 0, 1); PG8_STAGE(PG8_SB(0, 0), b2, voffB); PG8_STAGE(PG8_SB(0, 1), b2 + hstepB, voffB); PG8_STAGE(PG8_SA(0, 0), a2, voffA);
            PG8_WAIT_V(8); PG8_WAIT_L(0); PG8_BAR; PG8_MMA(1, 0, At, B0); PG8_MMA(1, 1, At, B1); PG8_BAR; PG8_SCHED;
            PG8_LDB(B0, 1, 0); PG8_LDB(B1, 1, 1); PG8_SCHED; PG8_LDA(At, 1, 0); PG8_STAGE(PG8_SA(0, 1), a2 + hstepA, voffA);
            PG8_WAIT_V(8); PG8_WAIT_L(0); PG8_BAR; PG8_MMA(0, 0, At, B0); PG8_MMA(0, 1, At, B1); PG8_BAR; PG8_SCHED;
            PG8_LDA(At, 1, 1); PG8_STAGE(PG8_SB(1, 0), b3, voffB); PG8_STAGE(PG8_SB(1, 1), b3 + hstepB, voffB); PG8_STAGE(PG8_SA(1, 0), a3, voffA);
            PG8_WAIT_V(8); PG8_WAIT_L(0); PG8_BAR; PG8_MMA(1, 0, At, B0); PG8_MMA(1, 1, At, B1); PG8_BAR; PG8_SCHED;
            } else {
            PG8_LDB(B0, 0, 0); PG8_SCHED; PG8_LDA(At, 0, 0); PG8_STAGE(PG8_SA(1, 1), a1 + hstepA, voffA);
            PG8_WAIT_L(8); PG8_BAR; PG8_WAIT_L(0); PG8_MMA(0, 0, At, B0); PG8_BAR; PG8_SCHED;
            PG8_LDB(B1, 0, 1); PG8_STAGE(PG8_SB(0, 0), b2, voffB);
            PG8_BAR; PG8_WAIT_L(0); PG8_MMA(0, 1, At, B1); PG8_BAR;
            PG8_LDA(At, 0, 1); PG8_STAGE(PG8_SA(0, 0), a2, voffA);
            PG8_BAR; PG8_WAIT_L(0); PG8_MMA(1, 0, At, B0); PG8_BAR; PG8_SCHED;
            PG8_STAGE(PG8_SB(0, 1), b2 + hstepB, voffB);
            PG8_WAIT_V(6); PG8_BAR; PG8_MMA(1, 1, At, B1); PG8_BAR;
            PG8_LDB(B0, 1, 0); PG8_SCHED; PG8_LDA(At, 1, 0); PG8_STAGE(PG8_SA(0, 1), a2 + hstepA, voffA);
            PG8_WAIT_L(8); PG8_BAR; PG8_WAIT_L(0); PG8_MMA(0, 0, At, B0); PG8_BAR; PG8_SCHED;
            PG8_LDB(B1, 1, 1); PG8_STAGE(PG8_SB(1, 0), b3, voffB);
            PG8_BAR; PG8_WAIT_L(0); PG8_MMA(0, 1, At, B1); PG8_BAR;
            PG8_LDA(At, 1, 1); PG8_STAGE(PG8_SA(1, 0), a3, voffA);
            PG8_BAR; PG8_WAIT_L(0); PG8_MMA(1, 0, At, B0); PG8_BAR; PG8_SCHED;
            PG8_STAGE(PG8_SB(1, 1), b3 + hstepB, voffB);
            PG8_WAIT_V(6); PG8_BAR; PG8_MMA(1, 1, At, B1); PG8_BAR;
            }
        }
        if constexpr (ALIGN_EPI) { if (wr == 0) PG8_BAR; }
        if constexpr (!Epi::AFTER_DRAIN) { E(acc, cur, wr, wc, fr, fq); S.done(cur); }
        if (!has_next) break;
#pragma unroll
        for (int a = 0; a < 2; ++a)
#pragma unroll
            for (int b = 0; b < 2; ++b)
#pragma unroll
                for (int m = 0; m < 4; ++m)
#pragma unroll
                    for (int n = 0; n < 2; ++n) acc[a][b][m][n] = (f32x4){0.f, 0.f, 0.f, 0.f};
        cur = nxt; cA = nA; cB = nB; ++ui;
        if constexpr (ALIGN_EPI) { if (wr == 1) PG8_BAR; }
    }
    PG8_WAIT_V(0);
    if constexpr (!ALIGN_EPI) { if (wr == 0) PG8_BAR; }
    PG8_BAR;
    if constexpr (Epi::AFTER_DRAIN) { E.fused(acc, cur, wr, wc, fr, fq, lds, wid, lane); S.done(cur); }
#undef PG8_SA
#undef PG8_SB
#undef PG8_STAGE
#undef PG8_LDA
#undef PG8_LDB
#undef PG8_MMA
#undef PG8_WAIT_V
#undef PG8_WAIT_L
#undef PG8_BAR
#undef PG8_SCHED
}
}
#define XB_TMO      128
#define XB_XCNT(j)  (256  + 64 * (j))
#define XB_XSUB(j)  (1280 + 64 * (j))
#define XB_XGEN(j)  (2304 + 64 * (j))
#define XB_TOP      3328
#define XB_TOPGEN   3392
#define XCD_BAR_WORDS 3456
#define XB_SPIN_CAP (1u << 20)
__device__ __forceinline__ unsigned xb_ld(unsigned* p)              { return __hip_atomic_load(p, __ATOMIC_RELAXED, __HIP_MEMORY_SCOPE_AGENT); }
__device__ __forceinline__ unsigned xb_add(unsigned* p, unsigned v) { return __hip_atomic_fetch_add(p, v, __ATOMIC_RELAXED, __HIP_MEMORY_SCOPE_AGENT); }
__device__ __forceinline__ unsigned xb_xcc_id() { return (unsigned)__builtin_amdgcn_s_getreg((3 << 11) | 20) & 0xFu; }
#define XB_SPIN(cond, bar) do { unsigned _sp = 0; while (cond) { __builtin_amdgcn_s_sleep(1); \
    if ((++_sp & 255u) == 0u) { if (xb_ld(&(bar)[XB_TMO])) break; if (_sp > XB_SPIN_CAP) { atomicAdd(&(bar)[XB_TMO], 1u); break; } } } } while (0)
struct XcdBarrier { unsigned* bar; unsigned x; volatile LAS unsigned* st; };
__device__ __forceinline__ XcdBarrier xcd_barrier_post(unsigned* bar, volatile LAS unsigned* st) {
    XcdBarrier b; b.bar = bar; b.x = xb_xcc_id(); b.st = st;
    if (threadIdx.x == 0) (void)xb_add(&bar[XB_XCNT(b.x)], 1u);
    return b;
}
__device__ __forceinline__ void xcd_barrier_complete(unsigned* bar, unsigned x, unsigned& nloc, unsigned& nx) {
    const unsigned G = gridDim.x * gridDim.y * gridDim.z;
    unsigned sum, cnt, mine, sp = 0u;
    for (;;) {
        sum = 0u; cnt = 0u; mine = 0u;
#pragma unroll
        for (unsigned j = 0; j < 16; ++j) { const unsigned c = xb_ld(&bar[XB_XCNT(j)]); sum += c; cnt += (c > 0u) ? 1u : 0u; mine = (j == x) ? c : mine; }
        if (sum == G) break;
        __builtin_amdgcn_s_sleep(1);
        if ((++sp & 255u) == 0u) { if (xb_ld(&bar[XB_TMO])) break; if (sp > XB_SPIN_CAP) { atomicAdd(&bar[XB_TMO], 1u); break; } }
    }
    nloc = mine > 0u ? mine : 1u; nx = cnt > 0u ? cnt : 1u;
}
__device__ __forceinline__ void xcd_barrier(const XcdBarrier& b) {
    asm volatile("s_waitcnt vmcnt(0)" ::: "memory");
    __syncthreads();
    if (threadIdx.x == 0) {
        unsigned* bar = b.bar;
        __builtin_amdgcn_s_waitcnt(0);
        unsigned nloc = b.st[0], nx = b.st[1];
        if (nloc == 0u) { xcd_barrier_complete(bar, b.x, nloc, nx); b.st[0] = nloc; b.st[1] = nx; }
        const unsigned old = xb_add(&bar[XB_XSUB(b.x)], 1u);
        const unsigned gen = old / nloc;
        if (old + 1u == (gen + 1u) * nloc) {
            __builtin_amdgcn_fence(__ATOMIC_RELEASE, "agent");
            asm volatile("s_waitcnt vmcnt(0)" ::: "memory");
            const unsigned og = xb_add(&bar[XB_TOP], 1u);
            const unsigned tg = og / nx;
            if (og + 1u == (tg + 1u) * nx) xb_add(&bar[XB_TOPGEN], 1u);
            else XB_SPIN(xb_ld(&bar[XB_TOPGEN]) == tg, bar);
            __builtin_amdgcn_fence(__ATOMIC_ACQUIRE, "agent");
            xb_add(&bar[XB_XGEN(b.x)], 1u);
            asm volatile("s_waitcnt vmcnt(0)" ::: "memory");
        } else {
            XB_SPIN(xb_ld(&bar[XB_XGEN(b.x)]) == gen, bar);
            __builtin_amdgcn_fence(__ATOMIC_ACQUIRE, "agent");
            asm volatile("s_waitcnt vmcnt(0)" ::: "memory");
        }
    }
    __syncthreads();
}

struct Args {
    const float* x; const float* mem; const float* norm_g; const float* w_in; const float* b_forget; const float* mem_norm_g; const float* w_mem_kv; const float* w_out; const float* final_g;
    float* out; unsigned char* ws; int ph_lo, ph_hi;
};

__device__ __forceinline__ void p0_transpose_item(const float* W, int ldw, int src_col0, int k0, bf16* WT, int K, int dst_row0, LAS float* scr, int lane) {
#pragma unroll 8
    for (int i = 0; i < 32; ++i) { const int kk = 2 * i + (lane >> 5); scr[kk * 33 + (lane & 31)] = W[(size_t)(k0 + kk) * ldw + src_col0 + (lane & 31)]; }
    LDS_WAIT(); asm volatile("" ::: "memory");
    const int c = lane & 7;
#pragma unroll
    for (int j = 0; j < 4; ++j) { const int n = (lane >> 3) + 8 * j; const LAS float* s = scr + (8 * c) * 33 + n;
        v4u o; o.x = pk2(s[0 * 33], s[1 * 33]); o.y = pk2(s[2 * 33], s[3 * 33]); o.z = pk2(s[4 * 33], s[5 * 33]); o.w = pk2(s[6 * 33], s[7 * 33]);
        *(GAS v4u*)(WT + (size_t)(dst_row0 + n) * K + k0 + 8 * c) = o; }
    LDS_WAIT(); asm volatile("" ::: "memory");
}
typedef float f32x4 __attribute__((ext_vector_type(4)));
__device__ __forceinline__ float log_sigmoid_f(float z) { return fminf(z, 0.f) - log1pf(expf(-fabsf(z))); }

__device__ __forceinline__ void sincos_small(double x, double& c, double& s) {
    const double k = __builtin_rint(x * 0.6366197723675814);
    double r = __builtin_fma(-k, 1.5707963267948966, x); r = __builtin_fma(-k, 6.123233995736766e-17, r);
    const double r2 = r * r;
    double sp = -7.647163731819816e-13;
    sp = __builtin_fma(sp, r2, 1.6059043836821613e-10);
    sp = __builtin_fma(sp, r2, -2.505210838544172e-08);
    sp = __builtin_fma(sp, r2, 2.7557319223985893e-06);
    sp = __builtin_fma(sp, r2, -0.0001984126984126984);
    sp = __builtin_fma(sp, r2, 0.008333333333333333);
    sp = __builtin_fma(sp, r2, -0.16666666666666666);
    const double sr = __builtin_fma(sp * r2, r, r);
    double cp = 4.779477332387385e-14;
    cp = __builtin_fma(cp, r2, -1.1470745597729725e-11);
    cp = __builtin_fma(cp, r2, 2.08767569878681e-09);
    cp = __builtin_fma(cp, r2, -2.755731922398589e-07);
    cp = __builtin_fma(cp, r2, 2.48015873015873e-05);
    cp = __builtin_fma(cp, r2, -0.001388888888888889);
    cp = __builtin_fma(cp, r2, 0.041666666666666664);
    cp = __builtin_fma(cp, r2, -0.5);
    const double cr = __builtin_fma(cp, r2, 1.0);
    const int q = (int)k & 3;
    c = (q == 0) ? cr : (q == 1) ? -sr : (q == 2) ? -cr : sr;
    s = (q == 0) ? sr : (q == 1) ? cr : (q == 2) ? -sr : -cr;
}
__device__ __forceinline__ void p0_prologue(const Args& a, LAS unsigned char* lds, int vcu, int G, int wave, int lane, int tid) {
    bf16* Win_t = (bf16*)(a.ws + WS_WIN); bf16* Wout_t = (bf16*)(a.ws + WS_WOUT); bf16* Wmkv_t = (bf16*)(a.ws + WS_WMKV);
    float* rope = (float*)(a.ws + WS_ROPE); float* logf_ = (float*)(a.ws + WS_LOGF);
    bf16* XN = (bf16*)((unsigned char*)a.out + DO_XN); bf16* MN = (bf16*)((unsigned char*)a.out + DO_MN);
    LAS float* scr = (LAS float*)(lds + RING_OFF + wave * 8704);
    LAS float* wf = (LAS float*)(lds + RING_OFF + 81920);
    const int gw = vcu * NWAVES + wave, NGW = G * NWAVES;
    for (int idx = tid; idx < 12 * 1024; idx += NWAVES * 64) { const int k = idx / 12, j = idx % 12; wf[j * 1024 + k] = a.w_in[(size_t)k * INW + S_FLOG + j]; }
    constexpr int I_IN = 16 * 224, I_OUT = 32 * 32, I_MKV = 16 * 32, NITEMS = I_IN + I_OUT + I_MKV;
    for (int it = gw; it < NITEMS; it += NGW) {
        int r = it;
        if (r < I_IN) { const int kb = r / 224, nb = r % 224; p0_transpose_item(a.w_in, INW, src_col_of_dst(32 * nb), 64 * kb, Win_t, 1024, 32 * nb, scr, lane); continue; } r -= I_IN;
        if (r < I_OUT) { const int kb = r / 32, nb = r % 32; p0_transpose_item(a.w_out, 1024, 32 * nb, 64 * kb, Wout_t, 2048, 32 * nb, scr, lane); continue; } r -= I_OUT;
        { const int kb = r / 32, nb = r % 32; p0_transpose_item(a.w_mem_kv, 1024, 32 * nb, 64 * kb, Wmkv_t, 1024, 32 * nb, scr, lane); }
    }
    for (int idx = gw * 64 + lane; idx < SEQ * 8; idx += NGW * 64) { const int pos = idx >> 3, i = idx & 7;
        const double invf = (i == 0) ? 1.0 : (i == 1) ? 0.19392274474868576 : (i == 2) ? 0.03760603093086393 : (i == 3) ? 0.007292664737217109 : (i == 4) ? 0.001414213562373095
                          : (i == 5) ? 0.0002742481756762073 : (i == 6) ? 5.318295896944988e-05 : 1.031338537721246e-05;
        double cv, sv; sincos_small((double)pos * invf, cv, sv); rope[2 * idx] = (float)cv; rope[2 * idx + 1] = (float)sv; }
    __syncthreads();
    f32x4 gv[4];
#pragma unroll
    for (int j = 0; j < 4; ++j) gv[j] = *(const f32x4*)(a.norm_g + 4 * lane + 256 * j);
    const float bfj = (lane < 12) ? a.b_forget[lane] : 0.f;
    for (int m = gw; m < M; m += NGW) {
        const GAS f32x4* xr = (const GAS f32x4*)(a.x + (size_t)m * DM) + lane;
        f32x4 v[4]; float s = 0.f;
#pragma unroll
        for (int j = 0; j < 4; ++j) { v[j] = xr[64 * j]; s += (v[j].x * v[j].x + v[j].y * v[j].y) + (v[j].z * v[j].z + v[j].w * v[j].w); }
        const float r = 1.0f / sqrtf(wave_sum(s) * (1.f / DM) + RMS_EPS);
#pragma unroll
        for (int j = 0; j < 4; ++j) v[j] = v[j] * r * gv[j];
        GAS unsigned long long* o8 = (GAS unsigned long long*)(XN + (size_t)m * DM) + lane;
#pragma unroll
        for (int j = 0; j < 4; ++j) o8[64 * j] = (unsigned long long)pk2(v[j].x, v[j].y) | ((unsigned long long)pk2(v[j].z, v[j].w) << 32);
        float mine = 0.f;
#pragma unroll 2
        for (int q = 0; q < 12; ++q) { float d = 0.f;
#pragma unroll
            for (int j = 0; j < 4; ++j) { const f32x4 w = *(const LAS f32x4*)(wf + q * 1024 + 256 * j + 4 * lane); d += (v[j].x * w.x + v[j].y * w.y) + (v[j].z * w.z + v[j].w * w.w); }
            d = wave_sum(d); if (lane == q) mine = d; }
        if (lane < 12) logf_[(size_t)m * 12 + lane] = log_sigmoid_f(mine + bfj);
    }
#pragma unroll
    for (int j = 0; j < 4; ++j) gv[j] = *(const f32x4*)(a.mem_norm_g + 4 * lane + 256 * j);
    for (int m = gw; m < MMEM; m += NGW) {
        const GAS f32x4* xr = (const GAS f32x4*)(a.mem + (size_t)m * DM) + lane;
        f32x4 v[4]; float s = 0.f;
#pragma unroll
        for (int j = 0; j < 4; ++j) { v[j] = xr[64 * j]; s += (v[j].x * v[j].x + v[j].y * v[j].y) + (v[j].z * v[j].z + v[j].w * v[j].w); }
        const float r = 1.0f / sqrtf(wave_sum(s) * (1.f / DM) + RMS_EPS);
#pragma unroll
        for (int j = 0; j < 4; ++j) v[j] = v[j] * r * gv[j];
        GAS unsigned long long* o8 = (GAS unsigned long long*)(MN + (size_t)m * DM) + lane;
#pragma unroll
        for (int j = 0; j < 4; ++j) o8[64 * j] = (unsigned long long)pk2(v[j].x, v[j].y) | ((unsigned long long)pk2(v[j].z, v[j].w) << 32);
    }
    __syncthreads();
}

__device__ __forceinline__ void fox_scan(const Args& a, int bh, int lane) {
    const float* logf_ = (const float*)(a.ws + WS_LOGF); v4u* kaug = (v4u*)(a.ws + WS_KAUG);
    const int b = bh / NH, h = bh % NH;
    float loc[32]; double tot = 0.0;
#pragma unroll
    for (int i = 0; i < 32; ++i) { loc[i] = logf_[((size_t)(b * SEQ + lane * 32 + i)) * 12 + h]; tot += (double)loc[i]; }
    double inc = tot;
#pragma unroll
    for (int o = 1; o < 64; o <<= 1) { const double t = __shfl_up(inc, o); if (lane >= o) inc += t; }
    double run = inc - tot;
#pragma unroll
    for (int i = 0; i < 32; ++i) { run += (double)loc[i]; const float x = -(float)(run * 1.4426950408889634);
        const unsigned hi = f2bf(x); const float r1 = x - __uint_as_float(hi << 16); const unsigned mi = f2bf(r1); const float r2 = r1 - __uint_as_float(mi << 16); const unsigned lo = f2bf(r2);
        v4u o; o.x = hi | (mi << 16); o.y = lo | (0x3f80u << 16); o.z = 0x3f80u | (0x3f80u << 16); o.w = 0u;
        kaug[(size_t)bh * SEQ + lane * 32 + i] = o; }
}

__device__ __forceinline__ void final_norm(const Args& a, int vcu, int G, int wave, int lane) {
    const float* ssq = (const float*)(a.ws + WS_SSQ);
    const int gw = vcu * NWAVES + wave, NGW = G * NWAVES;
    f32x4 gv[4];
#pragma unroll
    for (int j = 0; j < 4; ++j) gv[j] = *(const f32x4*)(a.final_g + 4 * lane + 256 * j);
    for (int m = gw; m < M; m += NGW) {
        float s = (lane < 16) ? ssq[(size_t)m * 16 + lane] : 0.f;
        s += __shfl_xor(s, 1); s += __shfl_xor(s, 2); s += __shfl_xor(s, 4); s += __shfl_xor(s, 8);
        s = __shfl(s, 0);
        const float r = 1.0f / sqrtf(s * (1.f / DM) + RMS_EPS);
        GAS f32x4* xr = (GAS f32x4*)(a.out + (size_t)m * DM) + lane;
#pragma unroll
        for (int j = 0; j < 4; ++j) { f32x4 v = xr[64 * j]; v = v * r * gv[j]; xr[64 * j] = v; }
    }
}
__device__ __forceinline__ void ld_row64(const bf16* p, float* f) {
    const v4u* q = (const v4u*)p;
#pragma unroll
    for (int i = 0; i < 8; ++i) { const v4u u = q[i]; f[8 * i + 0] = bflo(u.x); f[8 * i + 1] = bfhi(u.x); f[8 * i + 2] = bflo(u.y); f[8 * i + 3] = bfhi(u.y);
        f[8 * i + 4] = bflo(u.z); f[8 * i + 5] = bfhi(u.z); f[8 * i + 6] = bflo(u.w); f[8 * i + 7] = bfhi(u.w); }
}
__device__ __forceinline__ void st_row64_gated(bf16* dst, const bf16* gate, const float* o, float inv) {
    v4u* d = (v4u*)dst; const v4u* g = (const v4u*)gate;
#pragma unroll
    for (int i = 0; i < 8; ++i) { const v4u u = g[i]; v4u w;
        w.x = pk2(o[8 * i + 0] * inv * bflo(u.x), o[8 * i + 1] * inv * bfhi(u.x)); w.y = pk2(o[8 * i + 2] * inv * bflo(u.y), o[8 * i + 3] * inv * bfhi(u.y));
        w.z = pk2(o[8 * i + 4] * inv * bflo(u.z), o[8 * i + 5] * inv * bfhi(u.z)); w.w = pk2(o[8 * i + 6] * inv * bflo(u.w), o[8 * i + 7] * inv * bfhi(u.w)); d[i] = w; }
}
__device__ __forceinline__ float kaug_c(const v4u u) { return -((bflo(u.x) + bfhi(u.x)) + bflo(u.y)); }

__device__ __forceinline__ void fox_naive_body(unsigned char* ws, int blk, int tx) {
    bf16* P = (bf16*)(ws + WS_PROJ); const v4u* kaug = (const v4u*)(ws + WS_KAUG);
    const int qb = blk % 8, bh = blk / 8, b = bh / NH, h = bh % NH;
    const int t = qb * 256 + tx; const size_t row = (size_t)b * SEQ + t;
    float q[64], o[64], kv[64];
    ld_row64(P + row * NPROJ + C_FQ + h * 64, q);
#pragma unroll
    for (int d = 0; d < 64; ++d) o[d] = 0.f;
    const float cq = kaug_c(kaug[(size_t)bh * SEQ + t]);
    float m = -1e30f, l = 0.f;
    const int kend = qb * 256 + 256;
    for (int k = 0; k < kend; ++k) {
        const size_t krow = (size_t)b * SEQ + k;
        ld_row64(P + krow * NPROJ + C_FK + h * 64, kv);
        float s = 0.f;
#pragma unroll
        for (int d = 0; d < 64; ++d) s += q[d] * kv[d];
        s += cq - kaug_c(kaug[(size_t)bh * SEQ + k]);
        ld_row64(P + krow * NPROJ + C_FV + h * 64, kv);
        if (k <= t) {
            const float mn = fmaxf(m, s), al = exp2f(m - mn), p = exp2f(s - mn);
            l = l * al + p; m = mn;
#pragma unroll
            for (int d = 0; d < 64; ++d) o[d] = o[d] * al + p * kv[d];
        }
    }
    st_row64_gated(P + row * NPROJ + C_FQ + h * 64, P + row * NPROJ + C_FG + h * 64, o, 1.0f / l);
}

__device__ __forceinline__ void dil_naive_body(unsigned char* ws, int blk, int tx) {
    bf16* P = (bf16*)(ws + WS_PROJ);
    const int qb = blk % 8, bh = blk / 8, b = bh / NH, h = bh % NH;
    const int t = qb * 256 + tx; const size_t row = (size_t)b * SEQ + t;
    float q[64], o[64], kv[64];
    ld_row64(P + row * NPROJ + C_DQ + h * 64, q);
#pragma unroll
    for (int d = 0; d < 64; ++d) o[d] = 0.f;
    float m = -1e30f, l = 0.f;
    for (int pat = 0; pat < 3; ++pat) {
        const int dil = (pat == 0) ? 1 : (pat == 1) ? 4 : 16;
        for (int j = 0; j <= 128; ++j) {
            const int k = t - j * dil;
            if (k >= 0) {
                const size_t krow = (size_t)b * SEQ + k;
                ld_row64(P + krow * NPROJ + C_DK + h * 64, kv);
                float s = 0.f;
#pragma unroll
                for (int d = 0; d < 64; ++d) s += q[d] * kv[d];
                ld_row64(P + krow * NPROJ + C_DV + h * 64, kv);
                const float mn = fmaxf(m, s), al = exp2f(m - mn), p = exp2f(s - mn);
                l = l * al + p; m = mn;
#pragma unroll
                for (int d = 0; d < 64; ++d) o[d] = o[d] * al + p * kv[d];
            }
        }
    }
    st_row64_gated(P + row * NPROJ + C_DQ + h * 64, P + row * NPROJ + C_DG + h * 64, o, 1.0f / l);
}

__device__ __forceinline__ void mem_naive_body(unsigned char* ws, const unsigned char* dout, int blk, int tx) {
    bf16* P = (bf16*)(ws + WS_PROJ); const bf16* MKV = (const bf16*)(dout + DO_MKV);
    const int gid = blk * 256 + tx, half = gid & 1, qi = gid >> 1;
    const int t = qi % SEQ, bm = qi / SEQ, mh = bm % MH, b = bm / MH; const size_t row = (size_t)b * SEQ + t;
    float q[64], o[64], kv[64];
    ld_row64(P + row * NPROJ + C_MQ + mh * 128 + half * 64, q);
#pragma unroll
    for (int d = 0; d < 64; ++d) o[d] = 0.f;
    float m = -1e30f, l = 0.f;
    for (int k = 0; k < MEMLEN; ++k) {
        const size_t krow = (size_t)b * MEMLEN + k;
        ld_row64(MKV + krow * 1024 + mh * 128 + half * 64, kv);
        float s = 0.f;
#pragma unroll
        for (int d = 0; d < 64; ++d) s += q[d] * kv[d];
        s += __shfl_xor(s, 1);
        ld_row64(MKV + krow * 1024 + 512 + mh * 128 + half * 64, kv);
        const float mn = fmaxf(m, s), al = exp2f(m - mn), p = exp2f(s - mn);
        l = l * al + p; m = mn;
#pragma unroll
        for (int d = 0; d < 64; ++d) o[d] = o[d] * al + p * kv[d];
    }
    st_row64_gated(P + row * NPROJ + C_MQ + mh * 128 + half * 64, P + row * NPROJ + C_MG + mh * 128 + half * 64, o, 1.0f / l);
}

__global__ void __launch_bounds__(256) fox_naive(unsigned char* ws) { fox_naive_body(ws, blockIdx.x, threadIdx.x); }
__global__ void __launch_bounds__(256) dil_naive(unsigned char* ws) { dil_naive_body(ws, blockIdx.x, threadIdx.x); }
__global__ void __launch_bounds__(256) mem_naive(unsigned char* ws, const unsigned char* dout) { mem_naive_body(ws, dout, blockIdx.x, threadIdx.x); }
__global__ void __launch_bounds__(NWAVES * 64, 2) fwd(Args args) {
    extern __shared__ __attribute__((aligned(16))) unsigned char lds_raw[];
    LAS unsigned char* lds = (LAS unsigned char*)lds_raw;
    volatile LAS unsigned* MISC = (volatile LAS unsigned*)(lds + MISC_OFF);
    const int tid = threadIdx.x, lane = tid & 63, wave = __builtin_amdgcn_readfirstlane(tid >> 6);
    const int G = gridDim.x; const int bx = blockIdx.x; const int vcu = (G % 8 == 0) ? (bx % 8) * (G / 8) + bx / 8 : bx;
    gu32* ctl = (gu32*)(args.ws + WS_CTL);
    for (int u = tid; u < (LDS_BYTES - LDSCTL_OFF) / 4; u += NWAVES * 64) ((LAS unsigned*)(lds + LDSCTL_OFF))[u] = 0u;
    __syncthreads();
    const int lo = args.ph_lo, hi = args.ph_hi;
    const bool multi = (hi - lo) > 1;
    XcdBarrier bar; bar.bar = (unsigned*)(ctl + CW_BAR); bar.x = 0; bar.st = nullptr;
    if (multi) bar = xcd_barrier_post((unsigned*)(ctl + CW_BAR), MISC + 8);
#define IN(k) (lo <= (k) && (k) < hi)
#define BOTH(k) (IN(k) && IN((k) + 1))
#define GRID_BAR() xcd_barrier(bar)

    bf16* Win_t = (bf16*)(args.ws + WS_WIN); bf16* Wout_t = (bf16*)(args.ws + WS_WOUT); bf16* Wmkv_t = (bf16*)(args.ws + WS_WMKV);
    bf16* PROJ = (bf16*)(args.ws + WS_PROJ);
    bf16* XN = (bf16*)((unsigned char*)args.out + DO_XN); bf16* MN = (bf16*)((unsigned char*)args.out + DO_MN); bf16* MKV = (bf16*)((unsigned char*)args.out + DO_MKV);

    if (IN(0)) { p0_prologue(args, lds, vcu, G, wave, lane, tid); if (BOTH(0)) GRID_BAR(); }

    if (IN(1)) {
        if (wave == 0) for (int bh = bx; bh < BATCH * NH; bh += G) fox_scan(args, bh, lane);
        { pg8::Gemm g{XN, Win_t, M, NPROJ, DM, DM}; pg8::StaticOrder S; S.init(M, NPROJ, G, bx);
          pg8::EpiProj E{PROJ, NPROJ, (const float*)(args.ws + WS_ROPE), C2, C2M};
          pg8::gemm_phase<pg8::EpiProj, pg8::StaticOrder, true, true>(lds + RING_OFF, g, S, E); }
        { pg8::Gemm g{MN, Wmkv_t, MMEM, 1024, DM, DM}; pg8::StaticOrder S; S.init(MMEM, 1024, G, (bx + G / 2) % G);
          pg8::EpiPlain E{MKV, 1024};
          pg8::gemm_phase<pg8::EpiPlain, pg8::StaticOrder, true, true>(lds + RING_OFF, g, S, E); }
        if (BOTH(1)) GRID_BAR();
    }

    if (IN(2)) {
        if (multi) {
            for (int it = bx; it < BATCH * NH * 4; it += G) fox_naive_body(args.ws, 2 * it + (tid >> 8), tid & 255);
            for (int it = bx; it < BATCH * NH * 4; it += G) dil_naive_body(args.ws, 2 * it + (tid >> 8), tid & 255);
            for (int it = bx; it < BATCH * MH * SEQ / 256; it += G) mem_naive_body(args.ws, (const unsigned char*)args.out, 2 * it + (tid >> 8), tid & 255);
        }
        if (BOTH(2)) GRID_BAR();
    }

    if (IN(3)) {
        pg8::Gemm g{PROJ, Wout_t, M, DM, 2048, NPROJ}; pg8::StaticOrder S; S.init(M, DM, G, bx);
        pg8::EpiRes E{args.x, args.out, DM, (float*)(args.ws + WS_SSQ)};
        pg8::gemm_phase<pg8::EpiRes, pg8::StaticOrder, true, true>(lds + RING_OFF, g, S, E);
        if (BOTH(3)) GRID_BAR();
    }

    if (IN(4)) final_norm(args, vcu, G, wave, lane);
#undef IN
#undef BOTH
#undef GRID_BAR
}

extern "C" void kernel_launch(void* const* d_in, const int* in_sizes, int n_in, void* d_out, int out_size, void* d_ws, size_t ws_size, hipStream_t stream) {
    static int grid = 0;
    if (grid == 0) {
        if (n_in != 9 || in_sizes[0] != M * DM || out_size != M * DM || ws_size < WS_END) { fprintf(stderr, "kernel_launch: unexpected shapes (n_in %d, in0 %d, out %d, ws %zu)\n", n_in, n_in > 0 ? in_sizes[0] : -1, out_size, ws_size); grid = -1; return; }
        int dev = 0, cus = 0;
        if (hipGetDevice(&dev) != hipSuccess || hipDeviceGetAttribute(&cus, hipDeviceAttributeMultiprocessorCount, dev) != hipSuccess) { grid = -1; return; }
        if (hipFuncSetAttribute((const void*)fwd, hipFuncAttributeMaxDynamicSharedMemorySize, LDS_BYTES) != hipSuccess) { fprintf(stderr, "kernel_launch: hipFuncSetAttribute failed\n"); grid = -1; return; }
        int per_cu = 0;
        if (hipOccupancyMaxActiveBlocksPerMultiprocessor(&per_cu, (const void*)fwd, NWAVES * 64, LDS_BYTES) != hipSuccess || per_cu < 1) fprintf(stderr, "kernel_launch: occupancy query says %d\n", per_cu);
        (void)hipGetLastError();
        grid = cus;
    }
    if (grid < 0) return;
    (void)hipMemsetAsync((char*)d_ws + WS_CTL, 0, CTL_ZERO_BYTES, stream);
    Args a{};
    a.x = (const float*)d_in[0]; a.mem = (const float*)d_in[1]; a.norm_g = (const float*)d_in[2]; a.w_in = (const float*)d_in[3]; a.b_forget = (const float*)d_in[4];
    a.mem_norm_g = (const float*)d_in[5]; a.w_mem_kv = (const float*)d_in[6]; a.w_out = (const float*)d_in[7]; a.final_g = (const float*)d_in[8];
    a.out = (float*)d_out; a.ws = (unsigned char*)d_ws;
#if N_LAUNCH_MODE == 0
    a.ph_lo = 0; a.ph_hi = 1; hipLaunchKernelGGL(fwd, dim3(grid), dim3(NWAVES * 64), LDS_BYTES, stream, a);
    a.ph_lo = 1; a.ph_hi = 2; hipLaunchKernelGGL(fwd, dim3(grid), dim3(NWAVES * 64), LDS_BYTES, stream, a);
    hipLaunchKernelGGL(fox_naive, dim3(BATCH * NH * 8), dim3(256), 0, stream, (unsigned char*)d_ws);
    hipLaunchKernelGGL(dil_naive, dim3(BATCH * NH * 8), dim3(256), 0, stream, (unsigned char*)d_ws);
    hipLaunchKernelGGL(mem_naive, dim3(BATCH * MH * SEQ * 2 / 256), dim3(256), 0, stream, (unsigned char*)d_ws, (const unsigned char*)d_out);
    a.ph_lo = 3; a.ph_hi = 4; hipLaunchKernelGGL(fwd, dim3(grid), dim3(NWAVES * 64), LDS_BYTES, stream, a);
    a.ph_lo = 4; a.ph_hi = 5; hipLaunchKernelGGL(fwd, dim3(grid), dim3(NWAVES * 64), LDS_BYTES, stream, a);
#else
    a.ph_lo = 0; a.ph_hi = 5; hipLaunchKernelGGL(fwd, dim3(grid), dim3(NWAVES * 64), LDS_BYTES, stream, a);
#endif
}
```

```cpp
#include <hip/hip_runtime.h>
#include <hip/hip_bf16.h>
#include <cstdio>
#include <cstdint>
#include <cmath>

constexpr int BATCH = 16, SEQ = 2048, DM = 1024, M = BATCH * SEQ;
constexpr int INW = 7180, NPROJ = 7168;
constexpr int MEMLEN = 256, MMEM = BATCH * MEMLEN;
constexpr int NH = 12, HD = 64, MH = 4, MHD = 128;
constexpr float RMS_EPS = 1e-6f;
constexpr float LOG2E = 1.4426950408889634f;
constexpr float C2 = 0.125f * LOG2E;
constexpr float C2M = 0.08838834764831845f * LOG2E;
constexpr int C_FQ = 0, C_DQ = 768, C_MQ = 1536, C_FK = 2048, C_FV = 2816, C_FG = 3584, C_DK = 4352, C_DV = 5120, C_DG = 5888, C_MG = 6656;
constexpr int S_FQ = 0, S_FK = 768, S_FV = 1536, S_FG = 2304, S_FLOG = 3072, S_DQ = 3084, S_DK = 3852, S_DV = 4620, S_DG = 5388, S_MQ = 6156, S_MG = 6668;
__host__ __device__ __forceinline__ int src_col_of_dst(int d) {
    if (d < 768) return S_FQ + d;
    if (d < 1536) return S_DQ + d - 768;
    if (d < 2048) return S_MQ + d - 1536;
    if (d < 2816) return S_FK + d - 2048;
    if (d < 3584) return S_FV + d - 2816;
    if (d < 4352) return S_FG + d - 3584;
    if (d < 5120) return S_DK + d - 4352;
    if (d < 5888) return S_DV + d - 5120;
    if (d < 6656) return S_DG + d - 5888;
    return S_MG + d - 6656;
}

constexpr size_t MiB = 1u << 20;
constexpr size_t WS_CTL = 0, CTL_ZERO_BYTES = 1 * MiB;
constexpr size_t WS_WIN = 2 * MiB;
constexpr size_t WS_WOUT = 16 * MiB;
constexpr size_t WS_WMKV = 20 * MiB;
constexpr size_t WS_ROPE = 22 * MiB;
constexpr size_t WS_LOGF = 23 * MiB;
constexpr size_t WS_KAUG = 25 * MiB;
constexpr size_t WS_SSQ = 31 * MiB;
constexpr size_t WS_PROJ = 34 * MiB;
constexpr size_t WS_END = WS_PROJ + (size_t)M * NPROJ * 2;
constexpr size_t DO_XN = 0;
constexpr size_t DO_MN = 64 * MiB;
constexpr size_t DO_MKV = 72 * MiB;
constexpr int CW_TMO = 0, CW_CODE = 1, CW_QUEUE = 64, CW_BAR = 4096;

constexpr int NWAVES = 8;
constexpr int RING_OFF = 0, RING_BYTES = 131072;
constexpr int LDSCTL_OFF = RING_BYTES, MISC_OFF = LDSCTL_OFF + 320;
constexpr int LDS_BYTES = 147456;

#define GAS __attribute__((address_space(1)))
#define LAS __attribute__((address_space(3)))
typedef unsigned short bf16;
typedef unsigned v4u __attribute__((ext_vector_type(4)));
typedef GAS unsigned gu32;
#define RLX_AGENT __ATOMIC_RELAXED, __HIP_MEMORY_SCOPE_AGENT
#define LDS_WAIT() asm volatile("s_waitcnt lgkmcnt(0)" ::: "memory")
#define VM_WAIT() asm volatile("s_waitcnt vmcnt(0)" ::: "memory")
__device__ __forceinline__ unsigned f2bf(float f) { unsigned u = __builtin_bit_cast(unsigned, f); return (u + 0x7fffu + ((u >> 16) & 1u)) >> 16; }
__device__ __forceinline__ unsigned pk2(float lo, float hi) { return f2bf(lo) | (f2bf(hi) << 16); }
__device__ __forceinline__ float bflo(unsigned u) { return __uint_as_float(u << 16); }
__device__ __forceinline__ float bfhi(unsigned u) { return __uint_as_float(u & 0xffff0000u); }
__device__ __forceinline__ float wave_sum(float v) {
#pragma unroll
    for (int o = 1; o < 64; o <<= 1) v += __shfl_xor(v, o);
    return v;
}

#ifndef N_LAUNCH_MODE
#define N_LAUNCH_MODE 1
#endif
#ifndef DIL_NAIVE
#define DIL_NAIVE 0
#endif
#ifndef MEM_NAIVE
#define MEM_NAIVE 0
#endif
#ifndef FOX_NAIVE
#define FOX_NAIVE 0
#endif
namespace pg8 {
#define PG8_LAS __attribute__((address_space(3)))
typedef unsigned short bf16_t;
typedef short bf16x8 __attribute__((ext_vector_type(8)));
typedef float f32x4 __attribute__((ext_vector_type(4)));
typedef unsigned u32x4 __attribute__((ext_vector_type(4)));
constexpr int BM = 256, BK = 64, HALF = 128, HTB = HALF * BK * 2  , STAGE_BYTES = 8 * HTB, NXCD = 8, WGM = 8;

__host__ __device__ __forceinline__ int lds_byte(int r, int c) { const int st = (r >> 4) * 2 + (c >> 5), rr = r & 15, cc = c & 31, ob = rr * 64 + cc * 2; return st * 1024 + (ob ^ (((ob >> 9) & 1) << 5)); }
__host__ __device__ __forceinline__ void stage_rc(int b, int& R, int& C) { const int st = b / 1024, sb = b % 1024, swz = sb ^ (((sb >> 9) & 1) << 5); R = (st >> 1) * 16 + swz / 64; C = (st & 1) * 32 + (swz % 64) / 2; }
__host__ __device__ __forceinline__ int perm32(int rho) { const int n = rho >> 4, i = rho & 15; return 8 * (i >> 2) + 4 * n + (i & 3); }

struct Unit { int pm, pn; };
struct Gemm { const bf16_t* A; const bf16_t* Bt; int M, N, K, lda; };

struct StaticOrder {
    int nM, nN, nwg, G, c;
    __host__ __device__ void init(int M, int N, int G_, int c_) { nM = M / BM; nN = N / BM; nwg = nM * nN; G = G_; c = c_; }
    __host__ __device__ bool next(int i, Unit& u) const {
        const long L = (long)i * G + c; if (L >= nwg) return false;
        int wgid = (int)L; { const int q = nwg / NXCD, r = nwg % NXCD, xcd = wgid % NXCD, off = wgid / NXCD; wgid = (xcd < r ? xcd * (q + 1) : r * (q + 1) + (xcd - r) * q) + off; }
        const int nig = WGM * nN, gid = wgid / nig, fm = gid * WGM, gsz = (nM - fm) < WGM ? (nM - fm) : WGM;
        u.pm = fm + ((wgid % nig) % gsz); u.pn = (wgid % nig) / gsz; return true;
    }
    __device__ __forceinline__ void a_ready(const Unit&) const {}
    __device__ __forceinline__ void done(const Unit&) const {}
};

__device__ __forceinline__ unsigned cvt_pk_bf16(float lo, float hi) { unsigned r; asm volatile("v_cvt_pk_bf16_f32 %0, %1, %2" : "=v"(r) : "v"(lo), "v"(hi)); return r; }
__device__ __forceinline__ float silu_f(float v) { return v * __builtin_amdgcn_rcpf(1.0f + __builtin_amdgcn_exp2f(-1.4426950408889634f * v)); }

struct EpiPlain {
    static constexpr bool PERM = true, AFTER_DRAIN = false;
    bf16_t* O; int ldc;
    __device__ __forceinline__ void operator()(const f32x4 (&acc)[2][2][4][2], const Unit& u, int wr, int wc, int fr, int fq) const {
        const int row0 = u.pm * BM + wr * 64 + fr, col0 = u.pn * BM + wc * 32 + 8 * fq;
#pragma unroll
        for (int ai = 0; ai < 2; ++ai)
#pragma unroll
            for (int m = 0; m < 4; ++m) { bf16_t* rowp = O + (size_t)(row0 + ai * HALF + m * 16) * ldc + col0;
#pragma unroll
                for (int bj = 0; bj < 2; ++bj) { const f32x4 v0 = acc[ai][bj][m][0], v1 = acc[ai][bj][m][1];
                    u32x4 w; w.x = cvt_pk_bf16(v0[0], v0[1]); w.y = cvt_pk_bf16(v0[2], v0[3]); w.z = cvt_pk_bf16(v1[0], v1[1]); w.w = cvt_pk_bf16(v1[2], v1[3]);
                    *(u32x4*)(rowp + bj * HALF) = w; } }
    }
};

struct EpiProj {
    static constexpr bool PERM = true, AFTER_DRAIN = false;
    bf16_t* O; int ldc; const float* rope;
    float c2, c2m;
    __device__ __forceinline__ void operator()(const f32x4 (&acc)[2][2][4][2], const Unit& u, int wr, int wc, int fr, int fq) const {
        const int pn = u.pn;
        int kind; float sc = 1.f;
        if (pn < 3) { kind = 1; sc = c2; } else if (pn < 6) { kind = 2; sc = c2; } else if (pn < 8) { kind = 1; sc = c2m; } else if (pn < 14) kind = 0;
        else if (pn < 17) kind = 4; else if (pn < 20) kind = 3; else if (pn < 23) kind = 0; else kind = 4;
        const bool do_rope = (kind == 2 || kind == 3) && ((wc & 1) == 0);
        const int row0 = u.pm * BM + wr * 64 + fr, col0 = pn * BM + wc * 32 + 8 * fq;
#pragma unroll
        for (int ai = 0; ai < 2; ++ai)
#pragma unroll
            for (int m = 0; m < 4; ++m) { const int row = row0 + ai * HALF + m * 16; bf16_t* rowp = O + (size_t)row * ldc + col0;
                f32x4 cs[4];
                if (do_rope) { const f32x4* rp = (const f32x4*)(rope + (size_t)(row & 2047) * 16);
#pragma unroll
                    for (int i = 0; i < 4; ++i) cs[i] = rp[i]; }
#pragma unroll
                for (int bj = 0; bj < 2; ++bj) { f32x4 v0 = acc[ai][bj][m][0], v1 = acc[ai][bj][m][1];
                    if (do_rope) {
                        float p[8], v[8] = {v0[0], v0[1], v0[2], v0[3], v1[0], v1[1], v1[2], v1[3]};
#pragma unroll
                        for (int e = 0; e < 8; ++e) p[e] = __shfl_xor(v[e], 16);
                        const float sg = (fq == 0) ? -1.f : 1.f;
#pragma unroll
                        for (int e = 0; e < 8; ++e) { const float c = cs[e >> 1][(e & 1) * 2], s = cs[e >> 1][(e & 1) * 2 + 1]; const float r = v[e] * c + sg * p[e] * s; if (fq < 2) v[e] = r; }
                        v0 = (f32x4){v[0], v[1], v[2], v[3]}; v1 = (f32x4){v[4], v[5], v[6], v[7]};
                    }
                    if (kind == 4) {
#pragma unroll
                        for (int e = 0; e < 4; ++e) { v0[e] = silu_f(v0[e]); v1[e] = silu_f(v1[e]); }
                    }
                    v0 = v0 * sc; v1 = v1 * sc;
                    u32x4 w; w.x = cvt_pk_bf16(v0[0], v0[1]); w.y = cvt_pk_bf16(v0[2], v0[3]); w.z = cvt_pk_bf16(v1[0], v1[1]); w.w = cvt_pk_bf16(v1[2], v1[3]);
                    *(u32x4*)(rowp + bj * HALF) = w; } }
    }
};

struct EpiRes {
    static constexpr bool PERM = false, AFTER_DRAIN = false;
    const float* base; float* out; int ldc; float* ssq;
    __device__ __forceinline__ void operator()(const f32x4 (&acc)[2][2][4][2], const Unit& u, int wr, int wc, int fr, int fq) const {
        const int col0 = u.pn * BM + wc * 32 + 4 * fq;
#pragma unroll
        for (int ai = 0; ai < 2; ++ai)
#pragma unroll
            for (int m = 0; m < 4; ++m) { const int row = u.pm * BM + ai * HALF + wr * 64 + m * 16 + fr; const size_t off = (size_t)row * ldc + col0; float s = 0.f;
#pragma unroll
                for (int bj = 0; bj < 2; ++bj)
#pragma unroll
                    for (int n = 0; n < 2; ++n) { const f32x4 bs = *(const f32x4*)(base + off + bj * HALF + n * 16); const f32x4 o = bs + acc[ai][bj][m][n];
                        *(f32x4*)(out + off + bj * HALF + n * 16) = o; s += (o[0] * o[0] + o[1] * o[1]) + (o[2] * o[2] + o[3] * o[3]); }
                s += __shfl_xor(s, 16); s += __shfl_xor(s, 32);
                if (fq == 0) ssq[(size_t)row * 16 + u.pn * 4 + wc] = s; }
    }
};

template <class Epi, class Sched, bool ALIGN_EPI = false, bool SP2 = false>
__device__ __forceinline__ void gemm_phase(PG8_LAS unsigned char* lds, const Gemm g, const Sched& S, const Epi& E) {
    const int tid = threadIdx.x, wid = __builtin_amdgcn_readfirstlane(tid >> 6), lane = tid & 63, wr = wid >> 2, wc = wid & 3, fr = lane & 15, fq = lane >> 4;
    const int K = g.K, nt = K / BK;
    unsigned voffA[2], voffB[2];
#pragma unroll
    for (int i = 0; i < 2; ++i) { int R, C; stage_rc(tid * 16 + i * 8192, R, C); const int Rb = Epi::PERM ? ((R & ~31) + perm32(R & 31)) : R;
        voffA[i] = (unsigned)(R * g.lda + C) * 2u; voffB[i] = (unsigned)(Rb * K + C) * 2u; }
    const size_t kstep = (size_t)(BK * 2);
    const size_t hstepA = (size_t)HALF * g.lda * 2, hstepB = (size_t)HALF * K * 2;
    const size_t tstepA = 2 * hstepA, tstepB = 2 * hstepB;
    const unsigned ldsw = (unsigned)wid * 1024u;
    const int aoff = lds_byte(wr * 64 + fr, fq * 8), boff = lds_byte(wc * 32 + fr, fq * 8);
#define PG8_SA(b, h) (((b) * 2 + (h)) * HTB)
#define PG8_SB(b, h) ((4 + (b) * 2 + (h)) * HTB)
#define PG8_STAGE(bufoff, gbase, voff) do { _Pragma("unroll") for (int _i = 0; _i < 2; ++_i) \
        __builtin_amdgcn_global_load_lds((const unsigned*)((const char*)(gbase) + (voff)[_i]), (PG8_LAS unsigned*)(lds + (bufoff) + ldsw + _i * 8192), 16, 0, 0); } while (0)
#define PG8_LDA(dst, b, h) do { _Pragma("unroll") for (int m = 0; m < 4; ++m) _Pragma("unroll") for (int k = 0; k < 2; ++k) dst[m][k] = *(const PG8_LAS bf16x8*)(lds + PG8_SA(b, h) + aoff + m * 2048 + k * 1024); } while (0)
#define PG8_LDB(dst, b, h) do { _Pragma("unroll") for (int n = 0; n < 2; ++n) _Pragma("unroll") for (int k = 0; k < 2; ++k) dst[n][k] = *(const PG8_LAS bf16x8*)(lds + PG8_SB(b, h) + boff + n * 2048 + k * 1024); } while (0)
#define PG8_MMA(ai, bj, At, Bt) do { __builtin_amdgcn_s_setprio(1); _Pragma("unroll") for (int m = 0; m < 4; ++m) _Pragma("unroll") for (int n = 0; n < 2; ++n) _Pragma("unroll") for (int k = 0; k < 2; ++k) \
        acc[ai][bj][m][n] = __builtin_amdgcn_mfma_f32_16x16x32_bf16(Bt[n][k], At[m][k], acc[ai][bj][m][n], 0, 0, 0); __builtin_amdgcn_s_setprio(0); } while (0)
#define PG8_WAIT_V(n) asm volatile("s_waitcnt vmcnt(" #n ")" ::: "memory")
#define PG8_WAIT_L(n) asm volatile("s_waitcnt lgkmcnt(" #n ")" ::: "memory")
#define PG8_BAR __builtin_amdgcn_s_barrier()
#define PG8_SCHED __builtin_amdgcn_sched_barrier(0)
    Unit cur, nxt; int ui = 0;
    if (!S.next(0, cur)) return;
    f32x4 acc[2][2][4][2];
#pragma unroll
    for (int a = 0; a < 2; ++a)
#pragma unroll
        for (int b = 0; b < 2; ++b)
#pragma unroll
            for (int m = 0; m < 4; ++m)
#pragma unroll
                for (int n = 0; n < 2; ++n) acc[a][b][m][n] = (f32x4){0.f, 0.f, 0.f, 0.f};
    bf16x8 At[4][2], B0[2][2], B1[2][2];
    const char* cA = (const char*)g.A + (size_t)cur.pm * tstepA; const char* cB = (const char*)g.Bt + (size_t)cur.pn * tstepB;
    S.a_ready(cur);
    if constexpr (SP2) {
        PG8_STAGE(PG8_SB(0, 0), cB, voffB); PG8_STAGE(PG8_SB(0, 1), cB + hstepB, voffB); PG8_STAGE(PG8_SA(0, 0), cA, voffA); PG8_STAGE(PG8_SA(0, 1), cA + hstepA, voffA);
        if (wr == 1) PG8_BAR;
        PG8_WAIT_V(2); PG8_BAR;
        PG8_STAGE(PG8_SB(1, 0), cB + kstep, voffB); PG8_STAGE(PG8_SA(1, 0), cA + kstep, voffA); PG8_STAGE(PG8_SB(1, 1), cB + hstepB + kstep, voffB);
        PG8_WAIT_V(6); PG8_BAR;
    } else {
        PG8_STAGE(PG8_SB(0, 0), cB, voffB); PG8_STAGE(PG8_SA(0, 0), cA, voffA); PG8_STAGE(PG8_SB(0, 1), cB + hstepB, voffB); PG8_STAGE(PG8_SA(0, 1), cA + hstepA, voffA);
        if (wr == 1) PG8_BAR;
        PG8_WAIT_V(4); PG8_BAR;
        PG8_STAGE(PG8_SB(1, 0), cB + kstep, voffB); PG8_STAGE(PG8_SA(1, 0), cA + kstep, voffA); PG8_STAGE(PG8_SB(1, 1), cB + hstepB + kstep, voffB);
        PG8_WAIT_V(6); PG8_BAR;
    }
    for (;;) {
        const bool has_next = S.next(ui + 1, nxt);
        const char* nA = has_next ? (const char*)g.A + (size_t)nxt.pm * tstepA : cA; const char* nB = has_next ? (const char*)g.Bt + (size_t)nxt.pn * tstepB : cB;
        for (int t = 0; t < nt; t += 2) {
            const bool last = (t == nt - 2);
            const char* a1 = cA + (size_t)(t + 1) * kstep;
            const char* a2 = last ? nA : cA + (size_t)(t + 2) * kstep; const char* b2 = last ? nB : cB + (size_t)(t + 2) * kstep;
            const char* a3 = a2 + kstep; const char* b3 = b2 + kstep;
            if (last && has_next) S.a_ready(nxt);
            if constexpr (SP2) {
            PG8_LDB(B0, 0, 0); PG8_LDB(B1, 0, 1); PG8_SCHED; PG8_LDA(At, 0, 0); PG8_STAGE(PG8_SA(1, 1), a1 + hstepA, voffA);
            PG8_WAIT_V(8); PG8_WAIT_L(0); PG8_BAR; PG8_MMA(0, 0, At, B0); PG8_MMA(0, 1, At, B1); PG8_BAR; PG8_SCHED;
            PG8_LDA(At, 0, 1); PG8_STAGE(PG8_SB(0, 0), b2, voffB); PG8_STAGE(PG8_SB(0, 1), b2 + hstepB, voffB); PG8_STAGE(PG8_SA(0, 0), a2, voffA);
            PG8_WAIT_V(8); PG8_WAIT_L(0); PG8_BAR; PG8_MMA(1, 0, At, B0); PG8_MMA(1, 1, At, B1); PG8_BAR; PG8_SCHED;
            PG8_LDB(B0, 1, 0); PG8_LDB(B1, 1, 1); PG8_SCHED; PG8_LDA(At, 1, 0); PG8_STAGE(PG8_SA(0, 1), a2 + hstepA, voffA);
            PG8_WAIT_V(8); PG8_WAIT_L(0); PG8_BAR; PG8_MMA(0, 0, At, B0); PG8_MMA(0, 1, At, B1); PG8_BAR; PG8_SCHED;
            PG8_LDA(At, 1, 1); PG8_STAGE(PG8_SB(1, 0), b3, voffB); PG8_STAGE(PG8_SB(1, 1), b3 + hstepB, voffB); PG8_STAGE(PG8_SA(1, 0), a3, voffA);
            PG8_WAIT_V(8); PG8_WAIT_L(0); PG8_BAR; PG8_MMA(1, 0, At, B0); PG8_MMA(1, 1, At, B1); PG8_BAR; PG8_SCHED;
            } else {
            PG8_LDB(B0, 0, 0); PG8_SCHED; PG8_LDA(At, 0, 0); PG8_STAGE(PG8_SA(1, 1), a1 + hstepA, voffA);
            PG8_WAIT_L(8); PG8_BAR; PG8_WAIT_L(0); PG8_MMA(0, 0, At, B0); PG8_BAR; PG8_SCHED;
            PG8_LDB(B1, 0, 1); PG8_STAGE(PG8_SB(0, 0), b2, voffB);
            PG8_BAR; PG8_WAIT_L(0); PG8_MMA(0, 1, At, B1); PG8_BAR;
            PG8_LDA(At, 0, 1); PG8_STAGE(PG8_SA(0, 0), a2, voffA);
            PG8_BAR; PG8_WAIT_L(0); PG8_MMA(1, 0, At, B0); PG8_BAR; PG8_SCHED;
            PG8_STAGE(PG8_SB(0, 1), b2 + hstepB, voffB);
            PG8_WAIT_V(6); PG8_BAR; PG8_MMA(1, 1, At, B1); PG8_BAR;
            PG8_LDB(B0, 1, 0); PG8_SCHED; PG8_LDA(At, 1, 0); PG8_STAGE(PG8_SA(0, 1), a2 + hstepA, voffA);
            PG8_WAIT_L(8); PG8_BAR; PG8_WAIT_L(0); PG8_MMA(0, 0, At, B0); PG8_BAR; PG8_SCHED;
            PG8_LDB(B1, 1, 1); PG8_STAGE(PG8_SB(1, 0), b3, voffB);
            PG8_BAR; PG8_WAIT_L(0); PG8_MMA(0, 1, At, B1); PG8_BAR;
            PG8_LDA(At, 1, 1); PG8_STAGE(PG8_SA(1, 0), a3, voffA);
            PG8_BAR; PG8_WAIT_L(0); PG8_MMA(1, 0, At, B0); PG8_BAR; PG8_SCHED;
            PG8_STAGE(PG8_SB(1, 1), b3 + hstepB, voffB);
            PG8_WAIT_V(6); PG8_BAR; PG8_MMA(1, 1, At, B1); PG8_BAR;
            }
        }
        if constexpr (ALIGN_EPI) { if (wr == 0) PG8_BAR; }
        if constexpr (!Epi::AFTER_DRAIN) { E(acc, cur, wr, wc, fr, fq); S.done(cur); }
        if (!has_next) break;
#pragma unroll
        for (int a = 0; a < 2; ++a)
#pragma unroll
            for (int b = 0; b < 2; ++b)
#pragma unroll
                for (int m = 0; m < 4; ++m)
#pragma unroll
                    for (int n = 0; n < 2; ++n) acc[a][b][m][n] = (f32x4){0.f, 0.f, 0.f, 0.f};
        cur = nxt; cA = nA; cB = nB; ++ui;
        if constexpr (ALIGN_EPI) { if (wr == 1) PG8_BAR; }
    }
    PG8_WAIT_V(0);
    if constexpr (!ALIGN_EPI) { if (wr == 0) PG8_BAR; }
    PG8_BAR;
    if constexpr (Epi::AFTER_DRAIN) { E.fused(acc, cur, wr, wc, fr, fq, lds, wid, lane); S.done(cur); }
#undef PG8_SA
#undef PG8_SB
#undef PG8_STAGE
#undef PG8_LDA
#undef PG8_LDB
#undef PG8_MMA
#undef PG8_WAIT_V
#undef PG8_WAIT_L
#undef PG8_BAR
#undef PG8_SCHED
}
}
#define XB_TMO      128
#define XB_XCNT(j)  (256  + 64 * (j))
#define XB_XSUB(j)  (1280 + 64 * (j))
#define XB_XGEN(j)  (2304 + 64 * (j))
#define XB_TOP      3328
#define XB_TOPGEN   3392
#define XCD_BAR_WORDS 3456
#define XB_SPIN_CAP (1u << 20)
__device__ __forceinline__ unsigned xb_ld(unsigned* p)              { return __hip_atomic_load(p, __ATOMIC_RELAXED, __HIP_MEMORY_SCOPE_AGENT); }
__device__ __forceinline__ unsigned xb_add(unsigned* p, unsigned v) { return __hip_atomic_fetch_add(p, v, __ATOMIC_RELAXED, __HIP_MEMORY_SCOPE_AGENT); }
__device__ __forceinline__ unsigned xb_xcc_id() { return (unsigned)__builtin_amdgcn_s_getreg((3 << 11) | 20) & 0xFu; }
#define XB_SPIN(cond, bar) do { unsigned _sp = 0; while (cond) { __builtin_amdgcn_s_sleep(1); \
    if ((++_sp & 255u) == 0u) { if (xb_ld(&(bar)[XB_TMO])) break; if (_sp > XB_SPIN_CAP) { atomicAdd(&(bar)[XB_TMO], 1u); break; } } } } while (0)
struct XcdBarrier { unsigned* bar; unsigned x; volatile LAS unsigned* st; };
__device__ __forceinline__ XcdBarrier xcd_barrier_post(unsigned* bar, volatile LAS unsigned* st) {
    XcdBarrier b; b.bar = bar; b.x = xb_xcc_id(); b.st = st;
    if (threadIdx.x == 0) (void)xb_add(&bar[XB_XCNT(b.x)], 1u);
    return b;
}
__device__ __forceinline__ void xcd_barrier_complete(unsigned* bar, unsigned x, unsigned& nloc, unsigned& nx) {
    const unsigned G = gridDim.x * gridDim.y * gridDim.z;
    unsigned sum, cnt, mine, sp = 0u;
    for (;;) {
        sum = 0u; cnt = 0u; mine = 0u;
#pragma unroll
        for (unsigned j = 0; j < 16; ++j) { const unsigned c = xb_ld(&bar[XB_XCNT(j)]); sum += c; cnt += (c > 0u) ? 1u : 0u; mine = (j == x) ? c : mine; }
        if (sum == G) break;
        __builtin_amdgcn_s_sleep(1);
        if ((++sp & 255u) == 0u) { if (xb_ld(&bar[XB_TMO])) break; if (sp > XB_SPIN_CAP) { atomicAdd(&bar[XB_TMO], 1u); break; } }
    }
    nloc = mine > 0u ? mine : 1u; nx = cnt > 0u ? cnt : 1u;
}
__device__ __forceinline__ void xcd_barrier(const XcdBarrier& b) {
    asm volatile("s_waitcnt vmcnt(0)" ::: "memory");
    __syncthreads();
    if (threadIdx.x == 0) {
        unsigned* bar = b.bar;
        __builtin_amdgcn_s_waitcnt(0);
        unsigned nloc = b.st[0], nx = b.st[1];
        if (nloc == 0u) { xcd_barrier_complete(bar, b.x, nloc, nx); b.st[0] = nloc; b.st[1] = nx; }
        const unsigned old = xb_add(&bar[XB_XSUB(b.x)], 1u);
        const unsigned gen = old / nloc;
        if (old + 1u == (gen + 1u) * nloc) {
            __builtin_amdgcn_fence(__ATOMIC_RELEASE, "agent");
            asm volatile("s_waitcnt vmcnt(0)" ::: "memory");
            const unsigned og = xb_add(&bar[XB_TOP], 1u);
            const unsigned tg = og / nx;
            if (og + 1u == (tg + 1u) * nx) xb_add(&bar[XB_TOPGEN], 1u);
            else XB_SPIN(xb_ld(&bar[XB_TOPGEN]) == tg, bar);
            __builtin_amdgcn_fence(__ATOMIC_ACQUIRE, "agent");
            xb_add(&bar[XB_XGEN(b.x)], 1u);
            asm volatile("s_waitcnt vmcnt(0)" ::: "memory");
        } else {
            XB_SPIN(xb_ld(&bar[XB_XGEN(b.x)]) == gen, bar);
            __builtin_amdgcn_fence(__ATOMIC_ACQUIRE, "agent");
            asm volatile("s_waitcnt vmcnt(0)" ::: "memory");
        }
    }
    __syncthreads();
}

struct Args {
    const float* x; const float* mem; const float* norm_g; const float* w_in; const float* b_forget; const float* mem_norm_g; const float* w_mem_kv; const float* w_out; const float* final_g;
    float* out; unsigned char* ws; int ph_lo, ph_hi;
};

__device__ __forceinline__ void p0_transpose_item(const float* W, int ldw, int src_col0, int k0, bf16* WT, int K, int dst_row0, LAS float* scr, int lane) {
#pragma unroll 8
    for (int i = 0; i < 32; ++i) { const int kk = 2 * i + (lane >> 5); scr[kk * 33 + (lane & 31)] = W[(size_t)(k0 + kk) * ldw + src_col0 + (lane & 31)]; }
    LDS_WAIT(); asm volatile("" ::: "memory");
    const int c = lane & 7;
#pragma unroll
    for (int j = 0; j < 4; ++j) { const int n = (lane >> 3) + 8 * j; const LAS float* s = scr + (8 * c) * 33 + n;
        v4u o; o.x = pk2(s[0 * 33], s[1 * 33]); o.y = pk2(s[2 * 33], s[3 * 33]); o.z = pk2(s[4 * 33], s[5 * 33]); o.w = pk2(s[6 * 33], s[7 * 33]);
        *(GAS v4u*)(WT + (size_t)(dst_row0 + n) * K + k0 + 8 * c) = o; }
    LDS_WAIT(); asm volatile("" ::: "memory");
}
typedef float f32x4 __attribute__((ext_vector_type(4)));
__device__ __forceinline__ float log_sigmoid_f(float z) { return fminf(z, 0.f) - log1pf(expf(-fabsf(z))); }

__device__ __forceinline__ void sincos_small(double x, double& c, double& s) {
    const double k = __builtin_rint(x * 0.6366197723675814);
    double r = __builtin_fma(-k, 1.5707963267948966, x); r = __builtin_fma(-k, 6.123233995736766e-17, r);
    const double r2 = r * r;
    double sp = -7.647163731819816e-13;
    sp = __builtin_fma(sp, r2, 1.6059043836821613e-10);
    sp = __builtin_fma(sp, r2, -2.505210838544172e-08);
    sp = __builtin_fma(sp, r2, 2.7557319223985893e-06);
    sp = __builtin_fma(sp, r2, -0.0001984126984126984);
    sp = __builtin_fma(sp, r2, 0.008333333333333333);
    sp = __builtin_fma(sp, r2, -0.16666666666666666);
    const double sr = __builtin_fma(sp * r2, r, r);
    double cp = 4.779477332387385e-14;
    cp = __builtin_fma(cp, r2, -1.1470745597729725e-11);
    cp = __builtin_fma(cp, r2, 2.08767569878681e-09);
    cp = __builtin_fma(cp, r2, -2.755731922398589e-07);
    cp = __builtin_fma(cp, r2, 2.48015873015873e-05);
    cp = __builtin_fma(cp, r2, -0.001388888888888889);
    cp = __builtin_fma(cp, r2, 0.041666666666666664);
    cp = __builtin_fma(cp, r2, -0.5);
    const double cr = __builtin_fma(cp, r2, 1.0);
    const int q = (int)k & 3;
    c = (q == 0) ? cr : (q == 1) ? -sr : (q == 2) ? -cr : sr;
    s = (q == 0) ? sr : (q == 1) ? cr : (q == 2) ? -sr : -cr;
}
__device__ __forceinline__ void p0_prologue(const Args& a, LAS unsigned char* lds, int vcu, int G, int wave, int lane, int tid) {
    bf16* Win_t = (bf16*)(a.ws + WS_WIN); bf16* Wout_t = (bf16*)(a.ws + WS_WOUT); bf16* Wmkv_t = (bf16*)(a.ws + WS_WMKV);
    float* rope = (float*)(a.ws + WS_ROPE); float* logf_ = (float*)(a.ws + WS_LOGF);
    bf16* XN = (bf16*)((unsigned char*)a.out + DO_XN); bf16* MN = (bf16*)((unsigned char*)a.out + DO_MN);
    LAS float* scr = (LAS float*)(lds + RING_OFF + wave * 8704);
    LAS float* wf = (LAS float*)(lds + RING_OFF + 81920);
    const int gw = vcu * NWAVES + wave, NGW = G * NWAVES;
    for (int idx = tid; idx < 12 * 1024; idx += NWAVES * 64) { const int k = idx / 12, j = idx % 12; wf[j * 1024 + k] = a.w_in[(size_t)k * INW + S_FLOG + j]; }
    constexpr int I_IN = 16 * 224, I_OUT = 32 * 32, I_MKV = 16 * 32, NITEMS = I_IN + I_OUT + I_MKV;
    for (int it = gw; it < NITEMS; it += NGW) {
        int r = it;
        if (r < I_IN) { const int kb = r / 224, nb = r % 224; p0_transpose_item(a.w_in, INW, src_col_of_dst(32 * nb), 64 * kb, Win_t, 1024, 32 * nb, scr, lane); continue; } r -= I_IN;
        if (r < I_OUT) { const int kb = r / 32, nb = r % 32; p0_transpose_item(a.w_out, 1024, 32 * nb, 64 * kb, Wout_t, 2048, 32 * nb, scr, lane); continue; } r -= I_OUT;
        { const int kb = r / 32, nb = r % 32; p0_transpose_item(a.w_mem_kv, 1024, 32 * nb, 64 * kb, Wmkv_t, 1024, 32 * nb, scr, lane); }
    }
    for (int idx = gw * 64 + lane; idx < SEQ * 8; idx += NGW * 64) { const int pos = idx >> 3, i = idx & 7;
        const double invf = (i == 0) ? 1.0 : (i == 1) ? 0.19392274474868576 : (i == 2) ? 0.03760603093086393 : (i == 3) ? 0.007292664737217109 : (i == 4) ? 0.001414213562373095
                          : (i == 5) ? 0.0002742481756762073 : (i == 6) ? 5.318295896944988e-05 : 1.031338537721246e-05;
        double cv, sv; sincos_small((double)pos * invf, cv, sv); rope[2 * idx] = (float)cv; rope[2 * idx + 1] = (float)sv; }
    __syncthreads();
    f32x4 gv[4];
#pragma unroll
    for (int j = 0; j < 4; ++j) gv[j] = *(const f32x4*)(a.norm_g + 4 * lane + 256 * j);
    const float bfj = (lane < 12) ? a.b_forget[lane] : 0.f;
    for (int m = gw; m < M; m += NGW) {
        const GAS f32x4* xr = (const GAS f32x4*)(a.x + (size_t)m * DM) + lane;
        f32x4 v[4]; float s = 0.f;
#pragma unroll
        for (int j = 0; j < 4; ++j) { v[j] = xr[64 * j]; s += (v[j].x * v[j].x + v[j].y * v[j].y) + (v[j].z * v[j].z + v[j].w * v[j].w); }
        const float r = 1.0f / sqrtf(wave_sum(s) * (1.f / DM) + RMS_EPS);
#pragma unroll
        for (int j = 0; j < 4; ++j) v[j] = v[j] * r * gv[j];
        GAS unsigned long long* o8 = (GAS unsigned long long*)(XN + (size_t)m * DM) + lane;
#pragma unroll
        for (int j = 0; j < 4; ++j) o8[64 * j] = (unsigned long long)pk2(v[j].x, v[j].y) | ((unsigned long long)pk2(v[j].z, v[j].w) << 32);
        float mine = 0.f;
#pragma unroll 2
        for (int q = 0; q < 12; ++q) { float d = 0.f;
#pragma unroll
            for (int j = 0; j < 4; ++j) { const f32x4 w = *(const LAS f32x4*)(wf + q * 1024 + 256 * j + 4 * lane); d += (v[j].x * w.x + v[j].y * w.y) + (v[j].z * w.z + v[j].w * w.w); }
            d = wave_sum(d); if (lane == q) mine = d; }
        if (lane < 12) logf_[(size_t)m * 12 + lane] = log_sigmoid_f(mine + bfj);
    }
#pragma unroll
    for (int j = 0; j < 4; ++j) gv[j] = *(const f32x4*)(a.mem_norm_g + 4 * lane + 256 * j);
    for (int m = gw; m < MMEM; m += NGW) {
        const GAS f32x4* xr = (const GAS f32x4*)(a.mem + (size_t)m * DM) + lane;
        f32x4 v[4]; float s = 0.f;
#pragma unroll
        for (int j = 0; j < 4; ++j) { v[j] = xr[64 * j]; s += (v[j].x * v[j].x + v[j].y * v[j].y) + (v[j].z * v[j].z + v[j].w * v[j].w); }
        const float r = 1.0f / sqrtf(wave_sum(s) * (1.f / DM) + RMS_EPS);
#pragma unroll
        for (int j = 0; j < 4; ++j) v[j] = v[j] * r * gv[j];
        GAS unsigned long long* o8 = (GAS unsigned long long*)(MN + (size_t)m * DM) + lane;
#pragma unroll
        for (int j = 0; j < 4; ++j) o8[64 * j] = (unsigned long long)pk2(v[j].x, v[j].y) | ((unsigned long long)pk2(v[j].z, v[j].w) << 32);
    }
    __syncthreads();
}

__device__ __forceinline__ void fox_scan(const Args& a, int bh, int lane) {
    const float* logf_ = (const float*)(a.ws + WS_LOGF); v4u* kaug = (v4u*)(a.ws + WS_KAUG);
    const int b = bh / NH, h = bh % NH;
    float loc[32]; double tot = 0.0;
#pragma unroll
    for (int i = 0; i < 32; ++i) { loc[i] = logf_[((size_t)(b * SEQ + lane * 32 + i)) * 12 + h]; tot += (double)loc[i]; }
    double inc = tot;
#pragma unroll
    for (int o = 1; o < 64; o <<= 1) { const double t = __shfl_up(inc, o); if (lane >= o) inc += t; }
    double run = inc - tot;
#pragma unroll
    for (int i = 0; i < 32; ++i) { run += (double)loc[i]; const float x = -(float)(run * 1.4426950408889634);
        const unsigned hi = f2bf(x); const float r1 = x - __uint_as_float(hi << 16); const unsigned mi = f2bf(r1); const float r2 = r1 - __uint_as_float(mi << 16); const unsigned lo = f2bf(r2);
        v4u o; o.x = hi | (mi << 16); o.y = lo | (0x3f80u << 16); o.z = 0x3f80u | (0x3f80u << 16); o.w = 0x3f80u;
        kaug[(size_t)bh * SEQ + lane * 32 + i] = o; }
}

__device__ __forceinline__ void final_norm(const Args& a, int vcu, int G, int wave, int lane) {
    const float* ssq = (const float*)(a.ws + WS_SSQ);
    const int gw = vcu * NWAVES + wave, NGW = G * NWAVES;
    f32x4 gv[4];
#pragma unroll
    for (int j = 0; j < 4; ++j) gv[j] = *(const f32x4*)(a.final_g + 4 * lane + 256 * j);
    for (int m = gw; m < M; m += NGW) {
        float s = (lane < 16) ? ssq[(size_t)m * 16 + lane] : 0.f;
        s += __shfl_xor(s, 1); s += __shfl_xor(s, 2); s += __shfl_xor(s, 4); s += __shfl_xor(s, 8);
        s = __shfl(s, 0);
        const float r = 1.0f / sqrtf(s * (1.f / DM) + RMS_EPS);
        GAS f32x4* xr = (GAS f32x4*)(a.out + (size_t)m * DM) + lane;
#pragma unroll
        for (int j = 0; j < 4; ++j) { f32x4 v = xr[64 * j]; v = v * r * gv[j]; xr[64 * j] = v; }
    }
}
namespace fox_body {
using bf16=__hip_bfloat16;
using bf16x8=__attribute__((ext_vector_type(8)))short;
using s16x4=__attribute__((ext_vector_type(4)))short;
using f32x16=__attribute__((ext_vector_type(16)))float;
using u32x4=__attribute__((ext_vector_type(4)))unsigned;
constexpr int BATCH=16,NHEAD=12,SEQ=2048,D=64,DM=7168;
constexpr int NW=8,QBLK=32,QB=QBLK*NW,KVBLK=64,NQB=SEQ/QB;
constexpr int ATTN_PITCH=DM, ATTN_UNIT_ROWS=QB;
__device__ __forceinline__ int crow(int r,int hi){return (r&3)+8*(r>>2)+4*hi;}
#define SBAR() __builtin_amdgcn_sched_barrier(0)
__device__ __forceinline__ void cmask(f32x16&p0,f32x16&p1,int jb,int qrel,int hi){
  const float NEG=-INFINITY; int kb=64*jb+4*hi;
  #pragma unroll
  for(int r=0;r<16;++r){int kv=kb+(r&3)+8*(r>>2); if(kv>qrel)p0[r]=NEG; if(kv+32>qrel)p1[r]=NEG;}
}

constexpr int NSLOT=3, SLOTB=8192;
constexpr int LDS_K=0, LDS_V=NSLOT*SLOTB, LDS_WS=2*NSLOT*SLOTB, LDS_OST=LDS_WS+NW*64*4, LDS_AUG=LDS_OST+NW*4096, LDS_BYTES=LDS_AUG+SEQ*16;
constexpr float C2=0.125f*1.4426950408889634f;
__device__ __forceinline__ void glds16(const void*gsrc,unsigned lds_dst){unsigned keep;
  asm volatile("s_mov_b32 %0, m0\n\ts_mov_b32 m0, %2\n\ts_nop 0\n\tglobal_load_lds_dwordx4 %1, off\n\ts_mov_b32 m0, %0":"=&s"(keep):"v"(gsrc),"s"(lds_dst):"memory");}
__device__ __forceinline__ float max3f(float a,float b,float c){float r;asm("v_max3_f32 %0, %1, %2, %3":"=v"(r):"v"(a),"v"(b),"v"(c));return r;}
__device__ __forceinline__ float max2f(float a,float b){float r;asm("v_max_f32_e32 %0, %1, %2":"=v"(r):"v"(a),"v"(b));return r;}
__device__ __forceinline__ float fadd_s(float a,float b){float r;asm("v_add_f32_e32 %0, %1, %2":"=v"(r):"v"(a),"v"(b));return r;}
__device__ __forceinline__ float fsub_s(float a,float b){float r;asm("v_sub_f32_e32 %0, %1, %2":"=v"(r):"v"(a),"v"(b));return r;}
typedef float f32x2_t __attribute__((ext_vector_type(2))); typedef __bf16 bf16x2_t __attribute__((ext_vector_type(2)));
__device__ __forceinline__ unsigned cvtpk_s(float lo,float hi){f32x2_t v={lo,hi};bf16x2_t b=__builtin_convertvector(v,bf16x2_t);return __builtin_bit_cast(unsigned,b);}
#define WAIT_BAR(N) asm volatile("s_waitcnt vmcnt(" #N ") lgkmcnt(0)\n\ts_barrier":::"memory")

__device__ __forceinline__ void qkt(f32x16&p0,f32x16&p1,const char*Kslot,const bf16x8*qr,bf16x8 ka0,bf16x8 ka1,bf16x8 qaug,int r32,int hi){
  const char*kb=Kslot+hi*1024+r32*16;
  const f32x16 z=f32x16{};
  p0=__builtin_amdgcn_mfma_f32_32x32x16_bf16(ka0,qaug,z,0,0,0);p1=__builtin_amdgcn_mfma_f32_32x32x16_bf16(ka1,qaug,z,0,0,0);
  #pragma unroll
  for(int d0=0;d0<4;++d0){
    const bf16x8 b0=*reinterpret_cast<const bf16x8*>(kb+d0*2048);
    const bf16x8 b1=*reinterpret_cast<const bf16x8*>(kb+d0*2048+512);
    p0=__builtin_amdgcn_mfma_f32_32x32x16_bf16(b0,qr[d0],p0,0,0,0);p1=__builtin_amdgcn_mfma_f32_32x32x16_bf16(b1,qr[d0],p1,0,0,0);}
}
__device__ __forceinline__ unsigned bf16r(float f){unsigned u=__builtin_bit_cast(unsigned,f);return (u+0x7fffu+((u>>16)&1u))>>16;}
typedef __attribute__((address_space(3))) const char* lds_cptr;
typedef short v4i16_t __attribute__((ext_vector_type(4)));
__device__ __forceinline__ void kload8(bf16x8*kf,lds_cptr kp){
  kf[0]=*(const __attribute__((address_space(3))) bf16x8*)(kp);      kf[1]=*(const __attribute__((address_space(3))) bf16x8*)(kp+512);
  kf[2]=*(const __attribute__((address_space(3))) bf16x8*)(kp+2048); kf[3]=*(const __attribute__((address_space(3))) bf16x8*)(kp+2560);
  kf[4]=*(const __attribute__((address_space(3))) bf16x8*)(kp+4096); kf[5]=*(const __attribute__((address_space(3))) bf16x8*)(kp+4608);
  kf[6]=*(const __attribute__((address_space(3))) bf16x8*)(kp+6144); kf[7]=*(const __attribute__((address_space(3))) bf16x8*)(kp+6656);
}
__device__ __forceinline__ void kload2(bf16x8*kf,lds_cptr kp,int j){ kf[2*j]=*(const __attribute__((address_space(3))) bf16x8*)(kp+j*2048); kf[2*j+1]=*(const __attribute__((address_space(3))) bf16x8*)(kp+j*2048+512); }
__device__ __forceinline__ s16x4 vtr(lds_cptr p){ return __builtin_bit_cast(s16x4,__builtin_amdgcn_ds_read_tr16_b64_v4i16((__attribute__((address_space(3))) v4i16_t*)p)); }
__device__ __forceinline__ float rowmax(const f32x16&p0,const f32x16&p1){
  float a=max3f(p0[0],p0[1],p1[0]),b=max3f(p0[2],p0[3],p1[1]);a=max3f(a,p1[2],p1[3]);
  #pragma unroll
  for(int r=4;r<16;r+=4){a=max3f(a,p0[r],p0[r+1]);b=max3f(b,p0[r+2],p0[r+3]);a=max3f(a,p1[r],p1[r+1]);b=max3f(b,p1[r+2],p1[r+3]);}
  const float m=max2f(a,b);
  auto rr=__builtin_amdgcn_permlane32_swap(__float_as_uint(m),__float_as_uint(m),false,false);
  return max2f(__uint_as_float(rr[0]),__uint_as_float(rr[1]));
}
__device__ __forceinline__ void pv(f32x16*o,int vb,bf16x8 pa0,bf16x8 pa1,bf16x8 pa2,bf16x8 pa3){
  #pragma unroll
  for(int d0=0;d0<2;++d0){s16x4 lo[4],hi[4];
    #pragma unroll
    for(int ks=0;ks<4;++ks){
      asm volatile("ds_read_b64_tr_b16 %0,%1 offset:%c2":"=&v"(lo[ks]):"v"(vb),"i"(d0*4096+ks*1024):"memory");
      asm volatile("ds_read_b64_tr_b16 %0,%1 offset:%c2":"=&v"(hi[ks]):"v"(vb),"i"(d0*4096+ks*1024+512):"memory");}
    asm volatile("s_waitcnt lgkmcnt(0)":::"memory");SBAR();
    #define PK(k) (bf16x8){lo[k][0],lo[k][1],lo[k][2],lo[k][3],hi[k][0],hi[k][1],hi[k][2],hi[k][3]}
    o[d0]=__builtin_amdgcn_mfma_f32_32x32x16_bf16(pa0,PK(0),o[d0],0,0,0);
    o[d0]=__builtin_amdgcn_mfma_f32_32x32x16_bf16(pa1,PK(1),o[d0],0,0,0);
    o[d0]=__builtin_amdgcn_mfma_f32_32x32x16_bf16(pa2,PK(2),o[d0],0,0,0);
    o[d0]=__builtin_amdgcn_mfma_f32_32x32x16_bf16(pa3,PK(3),o[d0],0,0,0);
    #undef PK
  }
}

#ifndef ATTN_STORE16
#define ATTN_STORE16(p,v) (*(u32x4*)(p)=(v))
#endif
template<int THRL> __device__ __forceinline__ void attn_unit(int b,int h,int qb,const bf16*Q,const bf16*__restrict__ K,const bf16*__restrict__ V,bf16*O,const bf16*__restrict__ G,const u32x4*__restrict__ kaug,char*shm){
  const int tid=threadIdx.x,lane=tid&63,r32=lane&31,hi=lane>>5; const int wid=__builtin_amdgcn_readfirstlane(tid>>6);
  const long rowbase=(long)b*SEQ; const int q0=qb*QB;
  const bf16*Qw=Q+(rowbase+q0+wid*QBLK)*DM+h*D;
  const bf16*Kh=K+rowbase*DM+h*D,*Vh=V+rowbase*DM+h*D;
  const unsigned lds0=(unsigned)(uintptr_t)shm;
  float*wsf=(float*)(shm+LDS_WS)+wid*64;
  const bf16*ksrc=Kh+(long)lane*DM+wid*8;
  const bf16*vsrc=Vh+(long)(16*(wid&3)+(lane>>2))*DM+(wid>>2)*32+(lane&3)*8;
  const unsigned kdst=lds0+LDS_K+wid*1024, vdst=lds0+LDS_V+wid*1024;
  #define DMA_K(t,slot) glds16(ksrc+(long)(NT-1-(t))*KVBLK*DM,(unsigned)__builtin_amdgcn_readfirstlane(kdst+(slot)))
  #define DMA_V(t,slot) glds16(vsrc+(long)(NT-1-(t))*KVBLK*DM,(unsigned)__builtin_amdgcn_readfirstlane(vdst+(slot)))
  const int vb0=(int)(lds0+LDS_V)+((lane>>4)&1)*32+(lane&3)*8+(4*hi+((lane&15)>>2))*64;
  const char*Kbase=shm+LDS_K; bf16x8 kf[8];
  const lds_cptr shm3=(lds_cptr)shm; const lds_cptr kp0=shm3+LDS_K+hi*1024+r32*16; const lds_cptr vp0=shm3+LDS_V+((lane>>4)&1)*32+(lane&3)*8+(4*hi+((lane&15)>>2))*64;
  const int NT=(q0+QB)/KVBLK;
  const u32x4*kaugh=kaug+(long)(b*NHEAD+h)*SEQ; u32x4 af[4];
  #pragma unroll
  for(int i=0;i<4;++i)af[i]=kaugh[i*512+tid];
  const u32x4 kq=kaugh[q0+wid*QBLK+r32];
  DMA_K(0,0);DMA_V(0,0);DMA_K(1,SLOTB);
  bf16x8 qr[4];
  #pragma unroll
  for(int d0=0;d0<4;++d0)qr[d0]=*reinterpret_cast<const bf16x8*>(&Qw[(long)r32*DM+d0*16+hi*8]);
  float mhat=0.f,l_reg=0.f;f32x16 o[2];o[0]=f32x16{};o[1]=f32x16{};
  #pragma unroll
  for(int i=0;i<4;++i)*(u32x4*)(shm+LDS_AUG+(i*512+tid)*16)=af[i];
  u32x4 qa; qa.x=hi?0u:0x3f803f80u; qa.y=hi?0u:(0x3f80u|(((kq.x&0xffffu)^0x8000u)<<16)); qa.z=hi?0u:(((kq.x>>16)^0x8000u)|(((kq.y&0xffffu)^0x8000u)<<16)); qa.w=0u;
  bf16x8 ka0,ka1; const f32x16 zacc=f32x16{};
  const lds_cptr augp=(lds_cptr)shm+LDS_AUG+r32*16; int augo=(NT-1)*1024;
  #define SETM() do{ qa.w=hi?0u:(bf16r(-mhat)&0xffffu); }while(0)
  #define QAF __builtin_bit_cast(bf16x8,qa)
  #define KALD(off) do{ ka0=*(const __attribute__((address_space(3))) bf16x8*)(augp+(off)); ka1=*(const __attribute__((address_space(3))) bf16x8*)(augp+(off)+512); }while(0)
  const int qrel=wid*QBLK+r32;
  #define CMASK(P0,P1,t) do{int jb_=3-(t); if(jb_>=0)cmask(P0,P1,jb_,qrel,hi);}while(0)
  bool resc=false;
  #define START(P0,P1) do{ const float rm=rowmax(P0,P1); resc=false; \
    { const float dl=__uint_as_float(bf16r(__builtin_fmaxf(rm,-64.f))<<16); mhat=dl; \
      _Pragma("unroll") for(int r=0;r<16;++r){P0[r]=fsub_s(P0[r],dl);P1[r]=fsub_s(P1[r],dl);} \
      SETM(); } \
    _Pragma("unroll") for(int r=0;r<16;++r)P0[r]=__builtin_amdgcn_exp2f(P0[r]); }while(0)
  #define RESC() do{ if(resc){ asm volatile("s_waitcnt lgkmcnt(0)":::"memory"); \
      _Pragma("unroll") for(int d_=0;d_<2;++d_) _Pragma("unroll") for(int r=0;r<16;++r)o[d_][r]*=wsf[crow(r,hi)]; } }while(0)
  f32x16 pA0,pA1,pB0,pB1;
  int sl_prev=0,sl_cur=0,sl_next=SLOTB;
  #define ROT() do{sl_prev=sl_cur;sl_cur=sl_next;sl_next=(sl_next==(NSLOT-1)*SLOTB)?0:sl_next+SLOTB;augo-=1024;}while(0)
  DMA_K(2,2*SLOTB);
  WAIT_BAR(3);
  KALD(augo);
  qkt(pA0,pA1,Kbase,qr,ka0,ka1,QAF,r32,hi);asm volatile("s_nop 15\n\ts_nop 7":"+v"(pA0),"+v"(pA1));CMASK(pA0,pA1,0);
  START(pA0,pA1);
  _Pragma("unroll") for(int r=0;r<16;++r)pA1[r]=__builtin_amdgcn_exp2f(pA1[r]);
  WAIT_BAR(0);
  DMA_K(3,0);DMA_V(1,SLOTB);
  ROT();
  kload8(kf,kp0+sl_cur); KALD(augo);
  WAIT_BAR(2);
  s16x4 vlo[8],vhi[8]; u32x4 pw0,pw1,pw2,pw3;
  #define PKW(P,B) cvtpk_s(P[B],P[B+1])
  #define PAF(k) __builtin_bit_cast(bf16x8,pw##k)
  #define VFR(i) (bf16x8){vlo[i][0],vlo[i][1],vlo[i][2],vlo[i][3],vhi[i][0],vhi[i][1],vhi[i][2],vhi[i][3]}
  #define PIN(x) asm volatile("":"+v"(x))
  #define MX3(a,b,c) __builtin_fmaxf(__builtin_fmaxf((a),(b)),(c))
  #define GAPA(MF,A0,A1,A2,A3,W0,W1,PW) do{ MF; sacc+=A0; sacc+=A1; sacc+=A2; sacc+=A3; PIN(sacc); W0; W1; PIN(PW); SBAR(); }while(0)
  #define EX(v) __builtin_amdgcn_exp2f(v)
  #define GAPB(MF,X,B) do{ MF; X[B]=EX(X[B]); X[B+1]=EX(X[B+1]); X[B+2]=EX(X[B+2]); X[B+3]=EX(X[B+3]); PIN(X); SBAR(); }while(0)
  #define VRD(i) do{ vlo[i]=vtr(vp_+(((i)>>2)*4096+((i)&3)*1024)); vhi[i]=vtr(vp_+(((i)>>2)*4096+((i)&3)*1024+512)); }while(0)
  #define KRD(G,j) do{ if(G){ kload2(kf,kp0+sl_next,j); if((j)==0){KALD(augo-1024);} SBAR(); } }while(0)
  #define STEP(C0,C1,P0,P1,t,GK,GV,GL) do{ SBAR(); \
    const lds_cptr vp_=vp0+sl_prev; \
    VRD(0); SBAR(); float sacc=(P0[0]+P0[1]); \
    C0=__builtin_amdgcn_mfma_f32_32x32x16_bf16(ka0,QAF,zacc,0,0,0); SBAR(); C1=__builtin_amdgcn_mfma_f32_32x32x16_bf16(ka1,QAF,zacc,0,0,0); SBAR(); \
    GAPA(C0=__builtin_amdgcn_mfma_f32_32x32x16_bf16(kf[0],qr[0],C0,0,0,0), P0[2],P0[3],P0[4],P0[5],     pw0[0]=PKW(P0,0), pw0[1]=PKW(P0,2), pw0); \
    VRD(4); SBAR(); GAPA(C1=__builtin_amdgcn_mfma_f32_32x32x16_bf16(kf[1],qr[0],C1,0,0,0), P0[6],P0[7],P0[8],P0[9],     pw0[2]=PKW(P0,4), pw0[3]=PKW(P0,6), pw0); \
    VRD(1); SBAR(); GAPA(C0=__builtin_amdgcn_mfma_f32_32x32x16_bf16(kf[2],qr[1],C0,0,0,0),   P0[10],P0[11],P0[12],P0[13], pw1[0]=PKW(P0,8), pw1[1]=PKW(P0,10), pw1); \
    VRD(5); SBAR(); GAPA(C1=__builtin_amdgcn_mfma_f32_32x32x16_bf16(kf[3],qr[1],C1,0,0,0),   P0[14],P0[15],P1[0],P1[1],   pw1[2]=PKW(P0,12),pw1[3]=PKW(P0,14), pw1); \
    VRD(2); SBAR(); GAPA(C0=__builtin_amdgcn_mfma_f32_32x32x16_bf16(kf[4],qr[2],C0,0,0,0),   P1[2],P1[3],P1[4],P1[5],     pw2[0]=PKW(P1,0), pw2[1]=PKW(P1,2), pw2); \
    VRD(6); SBAR(); GAPA(C1=__builtin_amdgcn_mfma_f32_32x32x16_bf16(kf[5],qr[2],C1,0,0,0),   P1[6],P1[7],P1[8],P1[9],     pw2[2]=PKW(P1,4), pw2[3]=PKW(P1,6), pw2); \
    VRD(3); SBAR(); GAPA(C0=__builtin_amdgcn_mfma_f32_32x32x16_bf16(kf[6],qr[3],C0,0,0,0),   P1[10],P1[11],P1[12],P1[13], pw3[0]=PKW(P1,8), pw3[1]=PKW(P1,10), pw3); \
    VRD(7); SBAR(); GAPA(C1=__builtin_amdgcn_mfma_f32_32x32x16_bf16(kf[7],qr[3],C1,0,0,0),   P1[14],P1[15],0.f,0.f,       pw3[2]=PKW(P1,12),pw3[3]=PKW(P1,14), pw3); \
    l_reg+=sacc; \
    if(GK){DMA_K((t)+3,sl_cur);} if(GV){DMA_V((t)+1,sl_next);} \
    CMASK(C0,C1,t); \
    { float a=MX3(C0[0],C0[1],C1[0]),b=MX3(C0[2],C0[3],C1[1]); a=MX3(a,C1[2],C1[3]); \
      _Pragma("unroll") for(int r=4;r<16;r+=4){a=MX3(a,C0[r],C0[r+1]);b=MX3(b,C0[r+2],C0[r+3]);a=MX3(a,C1[r],C1[r+1]);b=MX3(b,C1[r+2],C1[r+3]);} \
      float rm=__builtin_fmaxf(a,b); { auto rr=__builtin_amdgcn_permlane32_swap(__float_as_uint(rm),__float_as_uint(rm),false,false); rm=__builtin_fmaxf(__uint_as_float(rr[0]),__uint_as_float(rr[1])); } \
      resc=false; \
      if(__builtin_expect(__any(rm>(float)THRL),0)){ const float mn_=__uint_as_float(bf16r(mhat+__builtin_fmaxf(rm,0.f))<<16); const float dl=mn_-mhat; mhat=mn_; \
        _Pragma("unroll") for(int r=0;r<16;++r){C0[r]-=dl;C1[r]-=dl;} \
        SETM(); \
        const float f=__builtin_amdgcn_exp2f(-dl); l_reg*=f; if(hi==0)wsf[r32]=f; resc=true; } } \
    SBAR(); \
    GAPB(o[0]=__builtin_amdgcn_mfma_f32_32x32x16_bf16(PAF(0),VFR(0),o[0],0,0,0), C0,0); \
    GAPB(o[1]=__builtin_amdgcn_mfma_f32_32x32x16_bf16(PAF(0),VFR(4),o[1],0,0,0), C0,4); \
    KRD(GL,0); GAPB(o[0]=__builtin_amdgcn_mfma_f32_32x32x16_bf16(PAF(1),VFR(1),o[0],0,0,0), C0,8); \
    KRD(GL,1); GAPB(o[1]=__builtin_amdgcn_mfma_f32_32x32x16_bf16(PAF(1),VFR(5),o[1],0,0,0), C0,12); \
    KRD(GL,2); GAPB(o[0]=__builtin_amdgcn_mfma_f32_32x32x16_bf16(PAF(2),VFR(2),o[0],0,0,0), C1,0); \
    KRD(GL,3); GAPB(o[1]=__builtin_amdgcn_mfma_f32_32x32x16_bf16(PAF(2),VFR(6),o[1],0,0,0), C1,4); \
    GAPB(o[0]=__builtin_amdgcn_mfma_f32_32x32x16_bf16(PAF(3),VFR(3),o[0],0,0,0), C1,8); \
    GAPB(o[1]=__builtin_amdgcn_mfma_f32_32x32x16_bf16(PAF(3),VFR(7),o[1],0,0,0), C1,12); \
    }while(0)
  int t=1;
  for(;t+5<NT;t+=2){
    STEP(pB0,pB1,pA0,pA1,t,true,true,true);     WAIT_BAR(2); RESC(); ROT();
    STEP(pA0,pA1,pB0,pB1,t+1,true,true,true);   WAIT_BAR(2); RESC(); ROT();
  }
  #define ENDW(tt) do{ if((tt)+3<NT){WAIT_BAR(2);} else if((tt)+2<NT){WAIT_BAR(1);} else {WAIT_BAR(0);} }while(0)
  for(;t+1<NT;t+=2){
    STEP(pB0,pB1,pA0,pA1,t,(t+3<NT),(t+1<NT),(t+1<NT));       ENDW(t);   RESC(); ROT();
    STEP(pA0,pA1,pB0,pB1,t+1,(t+4<NT),(t+2<NT),(t+2<NT));     ENDW(t+1); RESC(); ROT();
  }
  STEP(pB0,pB1,pA0,pA1,NT-1,false,false,false); RESC();
  { float sacc=pB0[0]+pB0[1]; _Pragma("unroll") for(int r=2;r<16;++r)sacc+=pB0[r]; _Pragma("unroll") for(int r=0;r<16;++r)sacc+=pB1[r]; l_reg+=sacc;
    pw0=(u32x4){PKW(pB0,0),PKW(pB0,2),PKW(pB0,4),PKW(pB0,6)};pw1=(u32x4){PKW(pB0,8),PKW(pB0,10),PKW(pB0,12),PKW(pB0,14)};pw2=(u32x4){PKW(pB1,0),PKW(pB1,2),PKW(pB1,4),PKW(pB1,6)};pw3=(u32x4){PKW(pB1,8),PKW(pB1,10),PKW(pB1,12),PKW(pB1,14)};
    SBAR(); pv(o,vb0+sl_cur,PAF(0),PAF(1),PAF(2),PAF(3)); }
  #undef PKW
  #undef PAF
  #undef VFR
  #undef PIN
  #undef MX3
  #undef GAPA
  #undef GAPB
  #undef EX
  #undef VRD
  #undef KRD
  #undef STEP
  #undef ENDW
  {auto rr=__builtin_amdgcn_permlane32_swap(__float_as_uint(l_reg),__float_as_uint(l_reg),false,false);l_reg=__uint_as_float(rr[0])+__uint_as_float(rr[1]);}
  if(hi==0)wsf[32+r32]=l_reg;asm volatile("s_waitcnt lgkmcnt(0)":::"memory");
  float rli[16];
  #pragma unroll
  for(int r=0;r<16;++r)rli[r]=__builtin_amdgcn_rcpf(wsf[32+crow(r,hi)]);
  bf16*Ow=O+(rowbase+q0+wid*QBLK)*DM+h*D; const bf16*Gw=G+(rowbase+q0+wid*QBLK)*DM+h*D;
  u32x4 gt[4];
  #pragma unroll
  for(int i=0;i<4;++i)gt[i]=*(const u32x4*)(Gw+(long)(i*8+(lane>>3))*DM+(lane&7)*8);
  { bf16*stg=(bf16*)(shm+LDS_OST)+wid*2048;
    #pragma unroll
    for(int r=0;r<16;++r){const int orow=crow(r,hi);
      #pragma unroll
      for(int d0=0;d0<2;++d0)stg[orow*64+d0*32+r32]=__float2bfloat16(o[d0][r]*rli[r]);}
    asm volatile("s_waitcnt lgkmcnt(0)":::"memory");
    #pragma unroll
    for(int i=0;i<4;++i){const int row=i*8+(lane>>3),ch=lane&7; const u32x4 v=*(const u32x4*)(stg+row*64+ch*8); const u32x4 g=gt[i]; u32x4 w;
      #define GM(a,b) cvtpk_s(__uint_as_float((a)<<16)*__uint_as_float((b)<<16),__uint_as_float((a)&0xffff0000u)*__uint_as_float((b)&0xffff0000u))
      w.x=GM(v.x,g.x);w.y=GM(v.y,g.y);w.z=GM(v.z,g.z);w.w=GM(v.w,g.w);
      #undef GM
      ATTN_STORE16(Ow+(long)row*DM+ch*8,w);} }
  asm volatile("s_waitcnt lgkmcnt(0)\n\ts_barrier":::"memory");
  #undef DMA_K
  #undef DMA_V
  #undef SETM
  #undef QAF
  #undef KALD
  #undef CMASK
  #undef START
  #undef RESC
  #undef ROT
}
constexpr int ATTN_LDS_BYTES=LDS_BYTES;
struct AttnTensors { const bf16* Q; const bf16* K; const bf16* V; bf16* O; const bf16* G; const u32x4* kaug; };
struct AttnUnit { int bh; int qb; };
struct StaticOrder {
  int vcu;
  __device__ __forceinline__ explicit StaticOrder(int grid,int block):vcu((grid%8==0)?(block%8)*(grid/8)+block/8:block){}
  __device__ __forceinline__ bool next(int i,AttnUnit&u)const{ const int pr=3*vcu+(i>>1); if(i>=6||pr>=BATCH*NHEAD*4)return false; const int s=pr&3; u.bh=pr>>2; u.qb=(i&1)?s:7-s; return true; }
  __device__ __forceinline__ void a_ready(const AttnUnit&)const{}
  __device__ __forceinline__ void done(const AttnUnit&)const{}
};
template<class Sched,int THRL=8> __device__ __forceinline__ void attn_phase(char*lds,const AttnTensors&T,const Sched&S){
  AttnUnit u;
  for(int i=0;S.next(i,u);++i){ S.a_ready(u); attn_unit<THRL>(u.bh/NHEAD,u.bh%NHEAD,u.qb,T.Q,T.K,T.V,T.O,T.G,T.kaug,lds); S.done(u); }
}
#undef SBAR
#undef WAIT_BAR
}
namespace dil_body {
using bf16x8=__attribute__((ext_vector_type(8)))short;
using s16x4=__attribute__((ext_vector_type(4)))short;
using f32x16=__attribute__((ext_vector_type(16)))float;
using u32x4=__attribute__((ext_vector_type(4)))unsigned;
typedef unsigned short bf16;
typedef __attribute__((address_space(3))) char* lds_ptr;
typedef short v4i16_t __attribute__((ext_vector_type(4)));
typedef __attribute__((address_space(3))) float* lf32p; typedef __attribute__((address_space(3))) unsigned short* lb16p; typedef __attribute__((address_space(3))) u32x4* lu4p;
constexpr int PITCH=7168,SEQ=2048,NHEAD=12,SPAN=512;
constexpr int L_OS=0,L_MS=65536,L_LS=L_MS+2048,L_WS=L_LS+2048,L_V=L_WS+2048,VBUF=4352,VSUB=2112,LDS_BYTES=L_V+8*VBUF;
constexpr float THR=8.f;
__device__ __forceinline__ int crow(int r,int hi){return (r&3)+8*(r>>2)+4*hi;}
typedef float f32x2_t __attribute__((ext_vector_type(2))); typedef __bf16 bf16x2_t __attribute__((ext_vector_type(2)));
__device__ __forceinline__ unsigned cvtpk_s(float lo,float hi){f32x2_t v={lo,hi};bf16x2_t b=__builtin_convertvector(v,bf16x2_t);return __builtin_bit_cast(unsigned,b);}
__device__ __forceinline__ s16x4 vtr(lds_ptr p){ return __builtin_bit_cast(s16x4,__builtin_amdgcn_ds_read_tr16_b64_v4i16((__attribute__((address_space(3))) v4i16_t*)p)); }
__device__ __forceinline__ float swapmax(float m){auto rr=__builtin_amdgcn_permlane32_swap(__float_as_uint(m),__float_as_uint(m),false,false);return __builtin_fmaxf(__uint_as_float(rr[0]),__uint_as_float(rr[1]));}
__device__ __forceinline__ float swapsum(float m){auto rr=__builtin_amdgcn_permlane32_swap(__float_as_uint(m),__float_as_uint(m),false,false);return __uint_as_float(rr[0])+__uint_as_float(rr[1]);}

struct Tensors { const bf16* Q; const bf16* K; const bf16* V; const bf16* G; bf16* O; };

template<int PAT> __device__ __forceinline__ void task(const Tensors& T,long rowb,int hc,int d,int r,int uq0,int span0,lds_ptr lds,int wid,int lane){
  const int r32=lane&31,hi=lane>>5;
  const int tq=r+d*(uq0+r32);
  const int taub=r+d*uq0-span0;
  bf16x8 qr[4];
  { const bf16* qp=T.Q+(rowb+tq)*PITCH+hc+8*hi;
    #pragma unroll
    for(int d0=0;d0<4;++d0)qr[d0]=*(const bf16x8*)(qp+16*d0); }
  const int Thi=uq0>>5; const int Tlo=(Thi>=4)?Thi-4:0;
  bf16x8 kf[4]; u32x4 vr[4];
  #define LOADKV(Tt) do{ const bf16* kp_=T.K+(rowb+r+d*(32*(Tt)+r32))*PITCH+hc+8*hi; \
      _Pragma("unroll") for(int d0=0;d0<4;++d0)kf[d0]=*(const bf16x8*)(kp_+16*d0); \
      _Pragma("unroll") for(int i=0;i<4;++i){const int pc=lane+64*i; vr[i]=*(const u32x4*)(T.V+(rowb+r+d*(32*(Tt)+(pc>>3)))*PITCH+hc+8*(pc&7));} }while(0)
  LOADKV(Thi);
  const lf32p wsf=(lf32p)(lds+L_WS)+wid*64;
  const lds_ptr vb=lds+L_V+wid*VBUF;
  const lds_ptr vrd=vb+(4*hi+((lane&15)>>2))*64+((lane>>4)&1)*32+(lane&3)*8;
  float m,l; f32x16 o[2];
  if(PAT==0){ m=0.f; l=0.f; o[0]=f32x16{}; o[1]=f32x16{}; }
  else{
    const lf32p MS=(lf32p)(lds+L_MS); const lf32p LS=(lf32p)(lds+L_LS); const lb16p OS=(lb16p)(lds+L_OS);
    m=MS[taub+d*r32]; l=hi?0.f:LS[taub+d*r32];
    #pragma unroll
    for(int d0=0;d0<2;++d0)
      #pragma unroll
      for(int rr=0;rr<16;++rr)o[d0][rr]=__uint_as_float((unsigned)OS[(taub+d*crow(rr,hi))*64+32*d0+r32]<<16);
  }
  for(int Tt=Thi;Tt>=Tlo;--Tt){
    f32x16 p=f32x16{};
    #pragma unroll
    for(int d0=0;d0<4;++d0)p=__builtin_amdgcn_mfma_f32_32x32x16_bf16(kf[d0],qr[d0],p,0,0,0);
    #pragma unroll
    for(int i=0;i<4;++i){const int pc=lane+64*i,kv=pc>>3,c=pc&7; *(lu4p)(vb+(c>>2)*VSUB+kv*64+(c&3)*16)=vr[i];}
    if(Tt>Tlo){ LOADKV(Tt-1); }
    if(Tt==Thi){
      #pragma unroll
      for(int rr=0;rr<16;++rr)if(crow(rr,hi)>r32)p[rr]=-INFINITY;
    }
    if(Tt+4==Thi){
      #pragma unroll
      for(int rr=0;rr<16;++rr)if(crow(rr,hi)<r32)p[rr]=-INFINITY;
    }
    float mx=__builtin_fmaxf(__builtin_fmaxf(p[0],p[1]),__builtin_fmaxf(p[2],p[3]));
    #pragma unroll
    for(int rr=4;rr<16;rr+=4)mx=__builtin_fmaxf(mx,__builtin_fmaxf(__builtin_fmaxf(p[rr],p[rr+1]),__builtin_fmaxf(p[rr+2],p[rr+3])));
    mx=swapmax(mx);
    if(PAT==0&&Tt==Thi){ m=mx; }
    else if(__any(mx>m+THR)){
      const float dl=__builtin_fmaxf(mx-m,0.f),f=__builtin_amdgcn_exp2f(-dl); m+=dl; l*=f;
      if(hi==0)wsf[r32]=f;
      #pragma unroll
      for(int d0=0;d0<2;++d0)
        #pragma unroll
        for(int rr=0;rr<16;++rr)o[d0][rr]*=wsf[crow(rr,hi)];
    }
    float sacc=0.f;
    #pragma unroll
    for(int rr=0;rr<16;++rr){p[rr]=__builtin_amdgcn_exp2f(p[rr]-m);sacc+=p[rr];}
    l+=sacc;
    u32x4 pw0,pw1;
    pw0.x=cvtpk_s(p[0],p[1]);pw0.y=cvtpk_s(p[2],p[3]);pw0.z=cvtpk_s(p[4],p[5]);pw0.w=cvtpk_s(p[6],p[7]);
    pw1.x=cvtpk_s(p[8],p[9]);pw1.y=cvtpk_s(p[10],p[11]);pw1.z=cvtpk_s(p[12],p[13]);pw1.w=cvtpk_s(p[14],p[15]);
    #pragma unroll
    for(int d0=0;d0<2;++d0){
      const s16x4 a0=vtr(vrd+d0*VSUB),a1=vtr(vrd+d0*VSUB+512),b0=vtr(vrd+d0*VSUB+1024),b1=vtr(vrd+d0*VSUB+1536);
      const bf16x8 v0=(bf16x8){a0[0],a0[1],a0[2],a0[3],a1[0],a1[1],a1[2],a1[3]},v1=(bf16x8){b0[0],b0[1],b0[2],b0[3],b1[0],b1[1],b1[2],b1[3]};
      o[d0]=__builtin_amdgcn_mfma_f32_32x32x16_bf16(__builtin_bit_cast(bf16x8,pw0),v0,o[d0],0,0,0);
      o[d0]=__builtin_amdgcn_mfma_f32_32x32x16_bf16(__builtin_bit_cast(bf16x8,pw1),v1,o[d0],0,0,0);
    }
  }
  #undef LOADKV
  l=swapsum(l);
  if(PAT<2){
    const lf32p MS=(lf32p)(lds+L_MS); const lf32p LS=(lf32p)(lds+L_LS); const lb16p OS=(lb16p)(lds+L_OS);
    if(hi==0){ MS[taub+d*r32]=m; LS[taub+d*r32]=l; }
    #pragma unroll
    for(int d0=0;d0<2;++d0)
      #pragma unroll
      for(int rr=0;rr<16;rr+=2){ const unsigned w=cvtpk_s(o[d0][rr],o[d0][rr+1]);
        OS[(taub+d*crow(rr,hi))*64+32*d0+r32]=(bf16)(w&0xffffu); OS[(taub+d*crow(rr+1,hi))*64+32*d0+r32]=(bf16)(w>>16); }
  } else {
    if(hi==0)wsf[32+r32]=l;
    const lb16p stg=(lb16p)vb;
    #pragma unroll
    for(int rr=0;rr<16;rr+=2){ const int q0_=crow(rr,hi); const float i0=__builtin_amdgcn_rcpf(wsf[32+q0_]),i1=__builtin_amdgcn_rcpf(wsf[32+q0_+1]);
      #pragma unroll
      for(int d0=0;d0<2;++d0){ const unsigned w=cvtpk_s(o[d0][rr]*i0,o[d0][rr+1]*i1); stg[q0_*64+32*d0+r32]=(bf16)(w&0xffffu); stg[(q0_+1)*64+32*d0+r32]=(bf16)(w>>16); } }
    #pragma unroll
    for(int i=0;i<4;++i){ const int row=i*8+(lane>>3),ch=lane&7; const long grow=rowb+r+d*(uq0+row);
      const u32x4 v=*(lu4p)(stg+row*64+ch*8); const u32x4 g=*(const u32x4*)(T.G+grow*PITCH+hc+ch*8); u32x4 w;
      #define GM(a,b) cvtpk_s(__uint_as_float((a)<<16)*__uint_as_float((b)<<16),__uint_as_float((a)&0xffff0000u)*__uint_as_float((b)&0xffff0000u))
      w.x=GM(v.x,g.x);w.y=GM(v.y,g.y);w.z=GM(v.z,g.z);w.w=GM(v.w,g.w);
      #undef GM
      *(u32x4*)(T.O+grow*PITCH+hc+ch*8)=w; }
  }
}

__device__ __forceinline__ void unit(const Tensors& T,int un,char* shm){
  const int tid=threadIdx.x,lane=tid&63; const int wid=__builtin_amdgcn_readfirstlane(tid>>6);
  const int j=un&3,bh=un>>2,b=bh/NHEAD,h=bh%NHEAD; const long rowb=(long)b*SEQ; const int hc=h*64,span0=SPAN*j;
  const lds_ptr lds=(lds_ptr)shm;
  #pragma unroll 1
  for(int k=wid;k<16;k+=8) task<0>(T,rowb,hc,16,k,32*j,span0,lds,wid,lane);
  __syncthreads();
  #pragma unroll 1
  for(int k=wid;k<16;k+=8) task<1>(T,rowb,hc,4,k&3,128*j+32*(k>>2),span0,lds,wid,lane);
  __syncthreads();
  #pragma unroll 1
  for(int k=wid;k<16;k+=8) task<2>(T,rowb,hc,1,0,512*j+32*k,span0,lds,wid,lane);
  __syncthreads();
}
}
namespace mem_body {
using dil_body::bf16x8; using dil_body::s16x4; using dil_body::f32x16; using dil_body::u32x4; using dil_body::bf16; using dil_body::lds_ptr; using dil_body::lf32p; using dil_body::lb16p; using dil_body::lu4p;
using dil_body::crow; using dil_body::cvtpk_s; using dil_body::vtr; using dil_body::swapmax; using dil_body::swapsum;
constexpr int PITCH=7168,SEQ=2048,MLEN=256,KVP=1024;
constexpr int L_WS=0,L_V=2048,VSUB=2112,VBUF=8448,LDS_BYTES=L_V+8*VBUF;
constexpr float THR=8.f;
struct Tensors { const bf16* Q; const bf16* K; const bf16* V; const bf16* G; bf16* O; };

__device__ __forceinline__ void task(const Tensors& T,long qrow0,long krow0,int hc,lds_ptr lds,int wid,int lane){
  const int r32=lane&31,hi=lane>>5;
  bf16x8 qr[8];
  { const bf16* qp=T.Q+(qrow0+r32)*PITCH+hc+8*hi;
    #pragma unroll
    for(int d0=0;d0<8;++d0)qr[d0]=*(const bf16x8*)(qp+16*d0); }
  bf16x8 kf[8]; u32x4 vr[8];
  #define LOADKV(Tt) do{ const bf16* kp_=T.K+(krow0+32*(Tt)+r32)*KVP+hc+8*hi; \
      _Pragma("unroll") for(int d0=0;d0<8;++d0)kf[d0]=*(const bf16x8*)(kp_+16*d0); \
      _Pragma("unroll") for(int i=0;i<8;++i){const int pc=lane+64*i; vr[i]=*(const u32x4*)(T.V+(krow0+32*(Tt)+(pc>>4))*KVP+hc+8*(pc&15));} }while(0)
  LOADKV(0);
  const lf32p wsf=(lf32p)(lds+L_WS)+wid*64;
  const lds_ptr vb=lds+L_V+wid*VBUF;
  const lds_ptr vrd=vb+(4*hi+((lane&15)>>2))*64+((lane>>4)&1)*32+(lane&3)*8;
  float m=0.f,l=0.f; f32x16 o[4];
  #pragma unroll
  for(int d0=0;d0<4;++d0)o[d0]=f32x16{};
  #pragma unroll 1
  for(int Tt=0;Tt<MLEN/32;++Tt){
    f32x16 p=f32x16{};
    #pragma unroll
    for(int d0=0;d0<8;++d0)p=__builtin_amdgcn_mfma_f32_32x32x16_bf16(kf[d0],qr[d0],p,0,0,0);
    #pragma unroll
    for(int i=0;i<8;++i){const int pc=lane+64*i,kv=pc>>4,c=pc&15; *(lu4p)(vb+(c>>2)*VSUB+kv*64+(c&3)*16)=vr[i];}
    if(Tt+1<MLEN/32){ LOADKV(Tt+1); }
    float mx=__builtin_fmaxf(__builtin_fmaxf(p[0],p[1]),__builtin_fmaxf(p[2],p[3]));
    #pragma unroll
    for(int rr=4;rr<16;rr+=4)mx=__builtin_fmaxf(mx,__builtin_fmaxf(__builtin_fmaxf(p[rr],p[rr+1]),__builtin_fmaxf(p[rr+2],p[rr+3])));
    mx=swapmax(mx);
    if(Tt==0){ m=mx; }
    else if(__any(mx>m+THR)){
      const float dl=__builtin_fmaxf(mx-m,0.f),f=__builtin_amdgcn_exp2f(-dl); m+=dl; l*=f;
      if(hi==0)wsf[r32]=f;
      #pragma unroll
      for(int d0=0;d0<4;++d0)
        #pragma unroll
        for(int rr=0;rr<16;++rr)o[d0][rr]*=wsf[crow(rr,hi)];
    }
    float sacc=0.f;
    #pragma unroll
    for(int rr=0;rr<16;++rr){p[rr]=__builtin_amdgcn_exp2f(p[rr]-m);sacc+=p[rr];}
    l+=sacc;
    u32x4 pw0,pw1;
    pw0.x=cvtpk_s(p[0],p[1]);pw0.y=cvtpk_s(p[2],p[3]);pw0.z=cvtpk_s(p[4],p[5]);pw0.w=cvtpk_s(p[6],p[7]);
    pw1.x=cvtpk_s(p[8],p[9]);pw1.y=cvtpk_s(p[10],p[11]);pw1.z=cvtpk_s(p[12],p[13]);pw1.w=cvtpk_s(p[14],p[15]);
    #pragma unroll
    for(int d0=0;d0<4;++d0){
      const s16x4 a0=vtr(vrd+d0*VSUB),a1=vtr(vrd+d0*VSUB+512),b0=vtr(vrd+d0*VSUB+1024),b1=vtr(vrd+d0*VSUB+1536);
      const bf16x8 v0=(bf16x8){a0[0],a0[1],a0[2],a0[3],a1[0],a1[1],a1[2],a1[3]},v1=(bf16x8){b0[0],b0[1],b0[2],b0[3],b1[0],b1[1],b1[2],b1[3]};
      o[d0]=__builtin_amdgcn_mfma_f32_32x32x16_bf16(__builtin_bit_cast(bf16x8,pw0),v0,o[d0],0,0,0);
      o[d0]=__builtin_amdgcn_mfma_f32_32x32x16_bf16(__builtin_bit_cast(bf16x8,pw1),v1,o[d0],0,0,0);
    }
  }
  #undef LOADKV
  l=swapsum(l);
  if(hi==0)wsf[32+r32]=l;
  const lb16p stg=(lb16p)vb;
  #pragma unroll
  for(int rr=0;rr<16;rr+=2){ const int q0_=crow(rr,hi); const float i0=__builtin_amdgcn_rcpf(wsf[32+q0_]),i1=__builtin_amdgcn_rcpf(wsf[32+q0_+1]);
    #pragma unroll
    for(int d0=0;d0<4;++d0){ const unsigned w=cvtpk_s(o[d0][rr]*i0,o[d0][rr+1]*i1); stg[q0_*128+32*d0+r32]=(bf16)(w&0xffffu); stg[(q0_+1)*128+32*d0+r32]=(bf16)(w>>16); } }
  #pragma unroll
  for(int i=0;i<8;++i){ const int row=i*4+(lane>>4),ch=lane&15; const long grow=qrow0+row;
    const u32x4 v=*(lu4p)(stg+row*128+ch*8); const u32x4 g=*(const u32x4*)(T.G+grow*PITCH+hc+ch*8); u32x4 w;
    #define GM(a,b) cvtpk_s(__uint_as_float((a)<<16)*__uint_as_float((b)<<16),__uint_as_float((a)&0xffff0000u)*__uint_as_float((b)&0xffff0000u))
    w.x=GM(v.x,g.x);w.y=GM(v.y,g.y);w.z=GM(v.z,g.z);w.w=GM(v.w,g.w);
    #undef GM
    *(u32x4*)(T.O+grow*PITCH+hc+ch*8)=w; }
}
__device__ __forceinline__ void unit(const Tensors& T,int un,char* shm){
  const int tid=threadIdx.x,lane=tid&63; const int wid=__builtin_amdgcn_readfirstlane(tid>>6);
  const int qb=un&7,bm=un>>3,mh=bm&3,b=bm>>2;
  task(T,(long)b*SEQ+qb*256+wid*32,(long)b*MLEN,mh*128,(lds_ptr)shm,wid,lane);
  __syncthreads();
}
}
__device__ __forceinline__ void ld_row64(const bf16* p, float* f) {
    const v4u* q = (const v4u*)p;
#pragma unroll
    for (int i = 0; i < 8; ++i) { const v4u u = q[i]; f[8 * i + 0] = bflo(u.x); f[8 * i + 1] = bfhi(u.x); f[8 * i + 2] = bflo(u.y); f[8 * i + 3] = bfhi(u.y);
        f[8 * i + 4] = bflo(u.z); f[8 * i + 5] = bfhi(u.z); f[8 * i + 6] = bflo(u.w); f[8 * i + 7] = bfhi(u.w); }
}
__device__ __forceinline__ void st_row64_gated(bf16* dst, const bf16* gate, const float* o, float inv) {
    v4u* d = (v4u*)dst; const v4u* g = (const v4u*)gate;
#pragma unroll
    for (int i = 0; i < 8; ++i) { const v4u u = g[i]; v4u w;
        w.x = pk2(o[8 * i + 0] * inv * bflo(u.x), o[8 * i + 1] * inv * bfhi(u.x)); w.y = pk2(o[8 * i + 2] * inv * bflo(u.y), o[8 * i + 3] * inv * bfhi(u.y));
        w.z = pk2(o[8 * i + 4] * inv * bflo(u.z), o[8 * i + 5] * inv * bfhi(u.z)); w.w = pk2(o[8 * i + 6] * inv * bflo(u.w), o[8 * i + 7] * inv * bfhi(u.w)); d[i] = w; }
}
__device__ __forceinline__ float kaug_c(const v4u u) { return -((bflo(u.x) + bfhi(u.x)) + bflo(u.y)); }

__device__ __forceinline__ void fox_naive_body(unsigned char* ws, int blk, int tx) {
    bf16* P = (bf16*)(ws + WS_PROJ); const v4u* kaug = (const v4u*)(ws + WS_KAUG);
    const int qb = blk % 8, bh = blk / 8, b = bh / NH, h = bh % NH;
    const int t = qb * 256 + tx; const size_t row = (size_t)b * SEQ + t;
    float q[64], o[64], kv[64];
    ld_row64(P + row * NPROJ + C_FQ + h * 64, q);
#pragma unroll
    for (int d = 0; d < 64; ++d) o[d] = 0.f;
    const float cq = kaug_c(kaug[(size_t)bh * SEQ + t]);
    float m = -1e30f, l = 0.f;
    const int kend = qb * 256 + 256;
    for (int k = 0; k < kend; ++k) {
        const size_t krow = (size_t)b * SEQ + k;
        ld_row64(P + krow * NPROJ + C_FK + h * 64, kv);
        float s = 0.f;
#pragma unroll
        for (int d = 0; d < 64; ++d) s += q[d] * kv[d];
        s += cq - kaug_c(kaug[(size_t)bh * SEQ + k]);
        ld_row64(P + krow * NPROJ + C_FV + h * 64, kv);
        if (k <= t) {
            const float mn = fmaxf(m, s), al = exp2f(m - mn), p = exp2f(s - mn);
            l = l * al + p; m = mn;
#pragma unroll
            for (int d = 0; d < 64; ++d) o[d] = o[d] * al + p * kv[d];
        }
    }
    st_row64_gated(P + row * NPROJ + C_FQ + h * 64, P + row * NPROJ + C_FG + h * 64, o, 1.0f / l);
}

__device__ __forceinline__ void dil_naive_body(unsigned char* ws, int blk, int tx) {
    bf16* P = (bf16*)(ws + WS_PROJ);
    const int qb = blk % 8, bh = blk / 8, b = bh / NH, h = bh % NH;
    const int t = qb * 256 + tx; const size_t row = (size_t)b * SEQ + t;
    float q[64], o[64], kv[64];
    ld_row64(P + row * NPROJ + C_DQ + h * 64, q);
#pragma unroll
    for (int d = 0; d < 64; ++d) o[d] = 0.f;
    float m = -1e30f, l = 0.f;
    for (int pat = 0; pat < 3; ++pat) {
        const int dil = (pat == 0) ? 1 : (pat == 1) ? 4 : 16;
        for (int j = 0; j <= 128; ++j) {
            const int k = t - j * dil;
            if (k >= 0) {
                const size_t krow = (size_t)b * SEQ + k;
                ld_row64(P + krow * NPROJ + C_DK + h * 64, kv);
                float s = 0.f;
#pragma unroll
                for (int d = 0; d < 64; ++d) s += q[d] * kv[d];
                ld_row64(P + krow * NPROJ + C_DV + h * 64, kv);
                const float mn = fmaxf(m, s), al = exp2f(m - mn), p = exp2f(s - mn);
                l = l * al + p; m = mn;
#pragma unroll
                for (int d = 0; d < 64; ++d) o[d] = o[d] * al + p * kv[d];
            }
        }
    }
    st_row64_gated(P + row * NPROJ + C_DQ + h * 64, P + row * NPROJ + C_DG + h * 64, o, 1.0f / l);
}

__device__ __forceinline__ void mem_naive_body(unsigned char* ws, const unsigned char* dout, int blk, int tx) {
    bf16* P = (bf16*)(ws + WS_PROJ); const bf16* MKV = (const bf16*)(dout + DO_MKV);
    const int gid = blk * 256 + tx, half = gid & 1, qi = gid >> 1;
    const int t = qi % SEQ, bm = qi / SEQ, mh = bm % MH, b = bm / MH; const size_t row = (size_t)b * SEQ + t;
    float q[64], o[64], kv[64];
    ld_row64(P + row * NPROJ + C_MQ + mh * 128 + half * 64, q);
#pragma unroll
    for (int d = 0; d < 64; ++d) o[d] = 0.f;
    float m = -1e30f, l = 0.f;
    for (int k = 0; k < MEMLEN; ++k) {
        const size_t krow = (size_t)b * MEMLEN + k;
        ld_row64(MKV + krow * 1024 + mh * 128 + half * 64, kv);
        float s = 0.f;
#pragma unroll
        for (int d = 0; d < 64; ++d) s += q[d] * kv[d];
        s += __shfl_xor(s, 1);
        ld_row64(MKV + krow * 1024 + 512 + mh * 128 + half * 64, kv);
        const float mn = fmaxf(m, s), al = exp2f(m - mn), p = exp2f(s - mn);
        l = l * al + p; m = mn;
#pragma unroll
        for (int d = 0; d < 64; ++d) o[d] = o[d] * al + p * kv[d];
    }
    st_row64_gated(P + row * NPROJ + C_MQ + mh * 128 + half * 64, P + row * NPROJ + C_MG + mh * 128 + half * 64, o, 1.0f / l);
}

__global__ void __launch_bounds__(256) fox_naive(unsigned char* ws) { fox_naive_body(ws, blockIdx.x, threadIdx.x); }
__global__ void __launch_bounds__(256) dil_naive(unsigned char* ws) { dil_naive_body(ws, blockIdx.x, threadIdx.x); }
__global__ void __launch_bounds__(256) mem_naive(unsigned char* ws, const unsigned char* dout) { mem_naive_body(ws, dout, blockIdx.x, threadIdx.x); }
__global__ void __launch_bounds__(NWAVES * 64, 2) fwd(Args args) {
    extern __shared__ __attribute__((aligned(16))) unsigned char lds_raw[];
    LAS unsigned char* lds = (LAS unsigned char*)lds_raw;
    volatile LAS unsigned* MISC = (volatile LAS unsigned*)(lds + MISC_OFF);
    const int tid = threadIdx.x, lane = tid & 63, wave = __builtin_amdgcn_readfirstlane(tid >> 6);
    const int G = gridDim.x; const int bx = blockIdx.x; const int vcu = (G % 8 == 0) ? (bx % 8) * (G / 8) + bx / 8 : bx;
    gu32* ctl = (gu32*)(args.ws + WS_CTL);
    for (int u = tid; u < (LDS_BYTES - LDSCTL_OFF) / 4; u += NWAVES * 64) ((LAS unsigned*)(lds + LDSCTL_OFF))[u] = 0u;
    __syncthreads();
    const int lo = args.ph_lo, hi = args.ph_hi;
    const bool multi = (hi - lo) > 1;
    XcdBarrier bar; bar.bar = (unsigned*)(ctl + CW_BAR); bar.x = 0; bar.st = nullptr;
    if (multi) bar = xcd_barrier_post((unsigned*)(ctl + CW_BAR), MISC + 8);
#define IN(k) (lo <= (k) && (k) < hi)
#define BOTH(k) (IN(k) && IN((k) + 1))
#define GRID_BAR() xcd_barrier(bar)

    bf16* Win_t = (bf16*)(args.ws + WS_WIN); bf16* Wout_t = (bf16*)(args.ws + WS_WOUT); bf16* Wmkv_t = (bf16*)(args.ws + WS_WMKV);
    bf16* PROJ = (bf16*)(args.ws + WS_PROJ);
    bf16* XN = (bf16*)((unsigned char*)args.out + DO_XN); bf16* MN = (bf16*)((unsigned char*)args.out + DO_MN); bf16* MKV = (bf16*)((unsigned char*)args.out + DO_MKV);

    if (IN(0)) { p0_prologue(args, lds, vcu, G, wave, lane, tid); if (BOTH(0)) GRID_BAR(); }

    if (IN(1)) {
        if (wave == 0) for (int bh = bx; bh < BATCH * NH; bh += G) fox_scan(args, bh, lane);
        { pg8::Gemm g{XN, Win_t, M, NPROJ, DM, DM}; pg8::StaticOrder S; S.init(M, NPROJ, G, bx);
          pg8::EpiProj E{PROJ, NPROJ, (const float*)(args.ws + WS_ROPE), C2, C2M};
          pg8::gemm_phase<pg8::EpiProj, pg8::StaticOrder, true, true>(lds + RING_OFF, g, S, E); }
        { pg8::Gemm g{MN, Wmkv_t, MMEM, 1024, DM, DM}; pg8::StaticOrder S; S.init(MMEM, 1024, G, (bx + G / 2) % G);
          pg8::EpiPlain E{MKV, 1024};
          pg8::gemm_phase<pg8::EpiPlain, pg8::StaticOrder, true, true>(lds + RING_OFF, g, S, E); }
        if (BOTH(1)) GRID_BAR();
    }

    if (IN(2)) {
        if (multi) {
#if FOX_NAIVE
            for (int it = bx; it < BATCH * NH * 4; it += G) fox_naive_body(args.ws, 2 * it + (tid >> 8), tid & 255);
#else
            { const fox_body::AttnTensors AT{(const fox_body::bf16*)(PROJ + C_FQ), (const fox_body::bf16*)(PROJ + C_FK), (const fox_body::bf16*)(PROJ + C_FV), (fox_body::bf16*)(PROJ + C_FQ),
                                             (const fox_body::bf16*)(PROJ + C_FG), (const fox_body::u32x4*)(args.ws + WS_KAUG)};
              const fox_body::StaticOrder S(G, bx);
              fox_body::attn_phase<fox_body::StaticOrder>((char*)lds_raw + RING_OFF, AT, S); }
            __syncthreads();
#endif
#if DIL_NAIVE
            for (int it = bx; it < BATCH * NH * 4; it += G) dil_naive_body(args.ws, 2 * it + (tid >> 8), tid & 255);
#else
            { const dil_body::Tensors DT{PROJ + C_DQ, PROJ + C_DK, PROJ + C_DV, PROJ + C_DG, PROJ + C_DQ};
              for (int un = bx; un < BATCH * NH * 4; un += G) dil_body::unit(DT, un, (char*)lds_raw + RING_OFF); }
#endif
#if MEM_NAIVE
            for (int it = bx; it < BATCH * MH * SEQ / 256; it += G) mem_naive_body(args.ws, (const unsigned char*)args.out, 2 * it + (tid >> 8), tid & 255);
#else
            { const mem_body::Tensors MT{PROJ + C_MQ, MKV, MKV + 512, PROJ + C_MG, PROJ + C_MQ};
              for (int un = bx; un < BATCH * MH * 8; un += G) mem_body::unit(MT, un, (char*)lds_raw + RING_OFF); }
#endif
        }
        if (BOTH(2)) GRID_BAR();
    }

    if (IN(3)) {
        pg8::Gemm g{PROJ, Wout_t, M, DM, 2048, NPROJ}; pg8::StaticOrder S; S.init(M, DM, G, bx);
        pg8::EpiRes E{args.x, args.out, DM, (float*)(args.ws + WS_SSQ)};
        pg8::gemm_phase<pg8::EpiRes, pg8::StaticOrder, true, true>(lds + RING_OFF, g, S, E);
        if (BOTH(3)) GRID_BAR();
    }

    if (IN(4)) final_norm(args, vcu, G, wave, lane);
#undef IN
#undef BOTH
#undef GRID_BAR
}

extern "C" void kernel_launch(void* const* d_in, const int* in_sizes, int n_in, void* d_out, int out_size, void* d_ws, size_t ws_size, hipStream_t stream) {
    static int grid = 0;
    if (grid == 0) {
        if (n_in != 9 || in_sizes[0] != M * DM || out_size != M * DM || ws_size < WS_END) { fprintf(stderr, "kernel_launch: unexpected shapes (n_in %d, in0 %d, out %d, ws %zu)\n", n_in, n_in > 0 ? in_sizes[0] : -1, out_size, ws_size); grid = -1; return; }
        int dev = 0, cus = 0;
        if (hipGetDevice(&dev) != hipSuccess || hipDeviceGetAttribute(&cus, hipDeviceAttributeMultiprocessorCount, dev) != hipSuccess) { grid = -1; return; }
        if (hipFuncSetAttribute((const void*)fwd, hipFuncAttributeMaxDynamicSharedMemorySize, LDS_BYTES) != hipSuccess) { fprintf(stderr, "kernel_launch: hipFuncSetAttribute failed\n"); grid = -1; return; }
        int per_cu = 0;
        if (hipOccupancyMaxActiveBlocksPerMultiprocessor(&per_cu, (const void*)fwd, NWAVES * 64, LDS_BYTES) != hipSuccess || per_cu < 1) fprintf(stderr, "kernel_launch: occupancy query says %d\n", per_cu);
        (void)hipGetLastError();
        grid = cus;
    }
    if (grid < 0) return;
    (void)hipMemsetAsync((char*)d_ws + WS_CTL, 0, CTL_ZERO_BYTES, stream);
    Args a{};
    a.x = (const float*)d_in[0]; a.mem = (const float*)d_in[1]; a.norm_g = (const float*)d_in[2]; a.w_in = (const float*)d_in[3]; a.b_forget = (const float*)d_in[4];
    a.mem_norm_g = (const float*)d_in[5]; a.w_mem_kv = (const float*)d_in[6]; a.w_out = (const float*)d_in[7]; a.final_g = (const float*)d_in[8];
    a.out = (float*)d_out; a.ws = (unsigned char*)d_ws;
#if N_LAUNCH_MODE == 0
    a.ph_lo = 0; a.ph_hi = 1; hipLaunchKernelGGL(fwd, dim3(grid), dim3(NWAVES * 64), LDS_BYTES, stream, a);
    a.ph_lo = 1; a.ph_hi = 2; hipLaunchKernelGGL(fwd, dim3(grid), dim3(NWAVES * 64), LDS_BYTES, stream, a);
    hipLaunchKernelGGL(fox_naive, dim3(BATCH * NH * 8), dim3(256), 0, stream, (unsigned char*)d_ws);
    hipLaunchKernelGGL(dil_naive, dim3(BATCH * NH * 8), dim3(256), 0, stream, (unsigned char*)d_ws);
    hipLaunchKernelGGL(mem_naive, dim3(BATCH * MH * SEQ * 2 / 256), dim3(256), 0, stream, (unsigned char*)d_ws, (const unsigned char*)d_out);
    a.ph_lo = 3; a.ph_hi = 4; hipLaunchKernelGGL(fwd, dim3(grid), dim3(NWAVES * 64), LDS_BYTES, stream, a);
    a.ph_lo = 4; a.ph_hi = 5; hipLaunchKernelGGL(fwd, dim3(grid), dim3(NWAVES * 64), LDS_BYTES, stream, a);
#else
    a.ph_lo = 0; a.ph_hi = 5; hipLaunchKernelGGL(fwd, dim3(grid), dim3(NWAVES * 64), LDS_BYTES, stream, a);
#endif
}
```
